# Optimizing an MI355X kernel written in HIP

```python
import jax, jax.numpy as jnp
from jax import lax
import numpy as np

D_MODEL = 1024
BATCH = 32
SEQ = 256
DEPTH = 4
DEC_BATCH = 4
DEC_SEQ = 4096
PAST_LEN = 512

GRID_W = 64
N_HEADS_A = 8
HEAD_K = 128
HEAD_V = 128
D_A = N_HEADS_A * HEAD_V
N_GROUPS_B = 4
GROUP_B = 128
D_B = N_GROUPS_B * GROUP_B
CHUNK = 32
EPS = 1e-6
SPLITS = (D_A, 2 * D_A, 3 * D_A, 4 * D_A, 5 * D_A, 5 * D_A + D_B, 5 * D_A + 2 * D_B,
          5 * D_A + 2 * D_B + D_MODEL)
D_IN = 5 * D_A + 2 * D_B + 2 * D_MODEL

kernel_name = "hgrn2_fnet_gated_diffusion_step"


def rms_norm(x, w):
    xf = x.astype(jnp.float32)
    y = xf * lax.rsqrt(jnp.mean(xf * xf, axis=-1, keepdims=True) + EPS)
    return (y * w.astype(jnp.float32)).astype(x.dtype)


def layer_lower_bounds(lb_raw):
    p = jax.nn.softmax(lb_raw.astype(jnp.float32), axis=0)
    cs = jnp.cumsum(p, axis=0)
    return cs - cs[0:1]


def grid_pos_embed(length, d):
    rows = length // GRID_W
    r = jnp.repeat(jnp.arange(rows, dtype=jnp.float32), GRID_W)
    col = jnp.tile(jnp.arange(GRID_W, dtype=jnp.float32), rows)
    nf = d // 4
    freqs = 1.0 / (10000.0 ** (jnp.arange(nf, dtype=jnp.float32) / nf))

    def emb(p):
        a = p[:, None] * freqs[None, :]
        return jnp.concatenate([jnp.sin(a), jnp.cos(a)], axis=-1)

    return jnp.concatenate([emb(r), emb(col)], axis=-1)


def hgrn2_chunk_scan(q, log_f, k, v, s0):
    B, L, H, _ = q.shape
    n = L // CHUNK

    def to_chunks(t):
        return t.reshape(B, n, CHUNK, H, t.shape[-1]).transpose(1, 0, 3, 2, 4)

    qc, gc, kc, vc = to_chunks(q), to_chunks(log_f), to_chunks(k), to_chunks(v)
    mask = jnp.tril(jnp.ones((CHUNK, CHUNK), dtype=bool))[:, :, None]

    def step(S, inp):
        qi, gi, ki, vi = inp
        b = jnp.cumsum(gi, axis=-2)
        diff = b[..., :, None, :] - b[..., None, :, :]
        decay = jnp.exp(jnp.where(mask, diff, -jnp.inf))
        att = jnp.einsum('bhtc,bhsc,bhtsc->bhts', qi, ki, decay)
        o = (jnp.einsum('bhts,bhsv->bhtv', att, vi)
             + jnp.einsum('bhtc,bhcv->bhtv', qi * jnp.exp(b), S))
        b_last = b[..., -1:, :]
        S_new = (jnp.exp(b_last[..., 0, :])[..., None] * S
                 + jnp.einsum('bhsc,bhsv->bhcv', ki * jnp.exp(b_last - b), vi))
        return S_new, o

    S_fin, o = lax.scan(step, s0, (qc, gc, kc, vc))
    o = o.transpose(1, 0, 3, 2, 4).reshape(B, L, H, -1)
    return o, S_fin


def forget_gate(fpre, lb):
    lbh = lb.reshape(N_HEADS_A, HEAD_K)
    log_f = jnp.logaddexp(jnp.log(lbh), jnp.log1p(-lbh) + jax.nn.log_sigmoid(fpre))
    return log_f, 1.0 - jnp.exp(log_f)


def mixer(h, lb_f, lb_b, w_in, gnorm_w, w_pa, w_pb, w_o, s0_f, s0_b):
    B, L, _ = h.shape
    proj = h @ w_in
    q, ff, fb, vi, zA, u, zB, gA, gB = jnp.split(proj, SPLITS, axis=-1)

    def heads(t):
        return t.reshape(B, L, N_HEADS_A, -1).astype(jnp.float32)

    qh = jax.nn.silu(heads(q))
    vh = heads(vi)
    logf_f, k_f = forget_gate(heads(ff), lb_f)
    logf_b, k_b = forget_gate(heads(fb), lb_b)
    o_f, S_f = hgrn2_chunk_scan(qh, logf_f, k_f, vh, s0_f.astype(jnp.float32))
    o_b_rev, S_b = hgrn2_chunk_scan(qh[:, ::-1], logf_b[:, ::-1], k_b[:, ::-1], vh[:, ::-1],
                                    s0_b.astype(jnp.float32))
    o = o_f + o_b_rev[:, ::-1]
    o = o * lax.rsqrt(jnp.mean(o * o, axis=-1, keepdims=True) + EPS)
    o = o * gnorm_w.astype(jnp.float32).reshape(N_HEADS_A, HEAD_V)
    yA = (o.reshape(B, L, D_A) * jax.nn.silu(zA.astype(jnp.float32))).astype(h.dtype)

    ug = u.astype(jnp.float32).reshape(B, L, N_GROUPS_B, GROUP_B)
    yF = jnp.fft.fft2(ug, axes=(1, 3), norm='ortho').real.reshape(B, L, D_B)
    yB = (yF * jax.nn.silu(zB.astype(jnp.float32))).astype(h.dtype)

    merged = jax.nn.sigmoid(gA) * (yA @ w_pa) + jax.nn.sigmoid(gB) * (yB @ w_pb)
    return merged @ w_o, S_f, S_b


def setup_inputs(seed: int = 0) -> dict:
    key = jax.random.key(seed)
    ks = jax.random.split(key, 16)
    D = D_MODEL
    f32 = jnp.float32
    return {
        "x_prompt": jax.random.normal(ks[0], (BATCH, SEQ, D), f32),
        "x_sample": jax.random.normal(ks[1], (DEC_BATCH, DEC_SEQ, D), f32),
        "state_hgrn": 0.3 * jax.random.normal(ks[2], (DEC_BATCH, DEPTH, 2, N_HEADS_A, HEAD_K, HEAD_V), f32),
        "c": jax.random.normal(ks[3], (DEC_BATCH, D), f32),
        "c_ctx": jax.random.normal(ks[4], (D,), f32),
        "norm_w": 1.0 + 0.01 * jax.random.normal(ks[5], (DEPTH, D), f32),
        "w_ada": 0.5 * D ** -0.5 * jax.random.normal(ks[6], (DEPTH, D, 3 * D), f32),
        "b_ada": 0.02 * jax.random.normal(ks[7], (DEPTH, 3 * D), f32),
        "w_in": D ** -0.5 * jax.random.normal(ks[8], (DEPTH, D, D_IN), f32),
        "lb_raw": 0.5 * jax.random.normal(ks[9], (DEPTH, 2, D_A), f32),
        "gnorm_w": 1.0 + 0.01 * jax.random.normal(ks[10], (DEPTH, D_A), f32),
        "w_pa": D_A ** -0.5 * jax.random.normal(ks[11], (DEPTH, D_A, D), f32),
        "w_pb": D_B ** -0.5 * jax.random.normal(ks[12], (DEPTH, D_B, D), f32),
        "w_o": D ** -0.5 * jax.random.normal(ks[13], (DEPTH, D, D), f32),
        "final_norm_w": 1.0 + 0.01 * jax.random.normal(ks[14], (D,), f32),
    }


def reference(x_prompt, x_sample, state_hgrn, c, c_ctx, norm_w, w_ada, b_ada, w_in, lb_raw,
              gnorm_w, w_pa, w_pb, w_o, final_norm_w):
    D = D_MODEL
    lbs = layer_lower_bounds(lb_raw)
    xp = x_prompt
    xs = x_sample + grid_pos_embed(x_sample.shape[1], D).astype(x_sample.dtype)[None]
    Bp = xp.shape[0]
    zero_state = jnp.zeros((Bp, N_HEADS_A, HEAD_K, HEAD_V), jnp.float32)
    ctx_states = []
    for l in range(DEPTH):
        mod_p = jax.nn.silu(c_ctx) @ w_ada[l] + b_ada[l]
        sh_p, sc_p, gt_p = mod_p[:D], mod_p[D:2 * D], mod_p[2 * D:]
        hp = rms_norm(xp, norm_w[l]) * (1.0 + sc_p) + sh_p
        out_p, sf, sb = mixer(hp, lbs[l, 0], lbs[l, 1], w_in[l], gnorm_w[l], w_pa[l], w_pb[l],
                              w_o[l], zero_state, zero_state)
        xp = xp + gt_p * out_p
        ctx_states.append(jnp.stack([sf, sb], axis=1).astype(x_prompt.dtype))
        mod_s = jax.nn.silu(c) @ w_ada[l] + b_ada[l]
        sh_s, sc_s, gt_s = mod_s[:, None, :D], mod_s[:, None, D:2 * D], mod_s[:, None, 2 * D:]
        hs = rms_norm(xs, norm_w[l]) * (1.0 + sc_s) + sh_s
        out_s, _, _ = mixer(hs, lbs[l, 0], lbs[l, 1], w_in[l], gnorm_w[l], w_pa[l], w_pb[l],
                            w_o[l], state_hgrn[:, l, 0], state_hgrn[:, l, 1])
        xs = xs + gt_s * out_s
    y_prompt = rms_norm(xp, final_norm_w)
    y_sample = rms_norm(xs, final_norm_w)
    new_state = jnp.stack(ctx_states, axis=1)
    return (y_prompt, y_sample, new_state)
```

```cpp
#include <hip/hip_runtime.h>
#include <hip/hip_cooperative_groups.h>
#include <cstdio>
#include <cstdint>
namespace cg = cooperative_groups;

#define LAS __attribute__((address_space(3)))
typedef unsigned short u16;
typedef short bf16x8 __attribute__((ext_vector_type(8)));
typedef float f32x4 __attribute__((ext_vector_type(4)));
typedef unsigned u32x4 __attribute__((ext_vector_type(4)));
typedef unsigned u32x2 __attribute__((ext_vector_type(2)));

constexpr int DM = 1024, NTOK = 24576, NPROMPT = 8192, DEPTH = 4, NG1 = 8704, DIN = 8192;
constexpr int LDS_BYTES = 144 * 1024;
constexpr size_t MiB = 1u << 20;
constexpr size_t WS_MOD = 1 * MiB;
constexpr size_t WS_LBS = WS_MOD + 256 * 1024;
constexpr size_t WS_DFTP = 2 * MiB;
constexpr size_t WS_WIN = 4 * MiB;
constexpr size_t WS_WPA = 72 * MiB;
constexpr size_t WS_WPB = 80 * MiB;
constexpr size_t WS_WO = 84 * MiB;
constexpr size_t WS_DFTS = 92 * MiB;
constexpr size_t WS_H = 156 * MiB;
constexpr size_t WS_Q = 204 * MiB;
constexpr size_t WS_LF = 252 * MiB;
constexpr size_t WS_LB = 300 * MiB;
constexpr size_t WS_V = 348 * MiB;
constexpr size_t WS_ZA = 396 * MiB;
constexpr size_t WS_ZB = 444 * MiB;
constexpr size_t WS_GA = 468 * MiB;
constexpr size_t WS_GB = 516 * MiB;
constexpr size_t WS_UT = 564 * MiB;
constexpr size_t WS_YAB = 612 * MiB;
constexpr size_t WS_OF = 684 * MiB;
constexpr size_t WS_OB = 780 * MiB;
constexpr size_t WS_SLOC = 876 * MiB;
constexpr size_t WS_LSEG = 1 * MiB + 512 * 1024;
constexpr size_t WS_END = 889 * MiB;
constexpr size_t WS_MERGED = WS_OB;
constexpr size_t UT_SAMPLE_OFF = (size_t)32 * 512 * 512;

struct P {
  const float *x_prompt, *x_sample, *state, *c, *c_ctx, *norm_w, *w_ada, *b_ada, *w_in, *lb_raw, *gnorm_w, *w_pa, *w_pb, *w_o, *final_w;
  float* out; unsigned char* ws;
  unsigned char prog[64];
};

typedef float f32x2v __attribute__((ext_vector_type(2)));
typedef __bf16 bf16x2v __attribute__((ext_vector_type(2)));
__device__ __forceinline__ unsigned pk2(float lo, float hi) { const f32x2v v = {lo, hi}; const bf16x2v b = __builtin_convertvector(v, bf16x2v); return __builtin_bit_cast(unsigned, b); }
__device__ __forceinline__ u16 f2bf(float f) { unsigned u = __float_as_uint(f); u += 0x7FFFu + ((u >> 16) & 1u); return (u16)(u >> 16); }
__device__ __forceinline__ float bf2f(unsigned b) { return __uint_as_float(b << 16); }
__device__ __forceinline__ float bflo(unsigned w) { return __uint_as_float(w << 16); }
__device__ __forceinline__ float bfhi(unsigned w) { return __uint_as_float(w & 0xFFFF0000u); }
__device__ __forceinline__ float h2f(unsigned short h) { return (float)__builtin_bit_cast(_Float16, h); }
__device__ __forceinline__ unsigned short f2h(float f) { return __builtin_bit_cast(unsigned short, (_Float16)f); }
__device__ __forceinline__ float siluf(float x) { return x * __builtin_amdgcn_rcpf(1.f + __expf(-x)); }
__device__ __forceinline__ float sigmf(float x) { return __builtin_amdgcn_rcpf(1.f + __expf(-x)); }
__device__ __forceinline__ float wave_sum(float v) {
#pragma unroll
  for (int o = 1; o < 64; o <<= 1) v += __shfl_xor(v, o);
  return v;
}

namespace pg8 {
constexpr int BM = 256, BK = 64, HALF = 128, HTB = HALF * BK * 2, STAGE_BYTES = 8 * HTB, NXCD = 8, WGM = 4;
__host__ __device__ __forceinline__ int lds_byte(int r, int c) { const int st = (r >> 4) * 2 + (c >> 5), rr = r & 15, cc = c & 31, ob = rr * 64 + cc * 2; return st * 1024 + (ob ^ (((ob >> 9) & 1) << 5)); }
__host__ __device__ __forceinline__ void stage_rc(int b, int& R, int& C) { const int st = b / 1024, sb = b % 1024, swz = sb ^ (((sb >> 9) & 1) << 5); R = (st >> 1) * 16 + swz / 64; C = (st & 1) * 32 + (swz % 64) / 2; }
__host__ __device__ __forceinline__ int perm32(int rho) { const int n = rho >> 4, i = rho & 15; return 8 * (i >> 2) + 4 * n + (i & 3); }
struct Unit { int pm, pn; };
struct Gemm { const u16* A; const u16* Bt; int M, N, K; };
struct StaticOrder {
  int nM, nN, nwg, G, c;
  __device__ void init(int M, int N, int G_, int c_) { nM = M / BM; nN = N / BM; nwg = nM * nN; G = G_; c = c_; }
  __device__ bool next(int i, Unit& u) const {
    const long L = (long)i * G + c; if (c < 0 || L >= nwg) return false;
    int wgid = (int)L; { const int q = nwg / NXCD, r = nwg % NXCD, xcd = wgid % NXCD, off = wgid / NXCD; wgid = (xcd < r ? xcd * (q + 1) : r * (q + 1) + (xcd - r) * q) + off; }
    const int nig = WGM * nN, gid = wgid / nig, fm = gid * WGM, gsz = (nM - fm) < WGM ? (nM - fm) : WGM;
    u.pm = fm + ((wgid % nig) % gsz); u.pn = (wgid % nig) / gsz; return true;
  }
};
template <class Epi>
__device__ __forceinline__ void gemm_phase(LAS unsigned char* lds, const Gemm g, const StaticOrder& S, const Epi& E, const int tid) {
  const int wid = __builtin_amdgcn_readfirstlane(tid >> 6), lane = tid & 63, wr = wid >> 2, wc = wid & 3, fr = lane & 15, fq = lane >> 4;
  const int K = g.K, nt = K / BK;
  unsigned voffA[2], voffB[2];
#pragma unroll
  for (int i = 0; i < 2; ++i) { int R, C; stage_rc(tid * 16 + i * 8192, R, C); const int Rb = E.perm ? ((R & ~31) + perm32(R & 31)) : R;
    voffA[i] = (unsigned)(R * K + C) * 2u; voffB[i] = (unsigned)(Rb * K + C) * 2u; }
  const size_t kstep = (size_t)(BK * 2);
  const size_t hstep = (size_t)HALF * K * 2;
  const size_t tstep = 2 * hstep;
  const unsigned ldsw = (unsigned)wid * 1024u;
  const int aoff = lds_byte(wr * 64 + fr, fq * 8), boff = lds_byte(wc * 32 + fr, fq * 8);
#define PG8_SA(b, h) (((b) * 2 + (h)) * HTB)
#define PG8_SB(b, h) ((4 + (b) * 2 + (h)) * HTB)
#define PG8_STAGE(bufoff, gbase, voff) do { _Pragma("unroll") for (int _i = 0; _i < 2; ++_i) \
    __builtin_amdgcn_global_load_lds((const unsigned*)((const char*)(gbase) + (voff)[_i]), (LAS unsigned*)(lds + (bufoff) + ldsw + _i * 8192), 16, 0, 0); } while (0)
#define PG8_LDA(dst, b, h) do { _Pragma("unroll") for (int m = 0; m < 4; ++m) _Pragma("unroll") for (int k = 0; k < 2; ++k) dst[m][k] = *(const LAS bf16x8*)(lds + PG8_SA(b, h) + aoff + m * 2048 + k * 1024); } while (0)
#define PG8_LDB(dst, b, h) do { _Pragma("unroll") for (int n = 0; n < 2; ++n) _Pragma("unroll") for (int k = 0; k < 2; ++k) dst[n][k] = *(const LAS bf16x8*)(lds + PG8_SB(b, h) + boff + n * 2048 + k * 1024); } while (0)
#define PG8_MMA(ai, bj, At, Bt) do { __builtin_amdgcn_s_setprio(1); _Pragma("unroll") for (int m = 0; m < 4; ++m) _Pragma("unroll") for (int n = 0; n < 2; ++n) _Pragma("unroll") for (int k = 0; k < 2; ++k) \
    acc[ai][bj][m][n] = __builtin_amdgcn_mfma_f32_16x16x32_bf16(Bt[n][k], At[m][k], acc[ai][bj][m][n], 0, 0, 0); __builtin_amdgcn_s_setprio(0); } while (0)
#define PG8_WAIT_V(n) asm volatile("s_waitcnt vmcnt(" #n ")" ::: "memory")
#define PG8_WAIT_L(n) asm volatile("s_waitcnt lgkmcnt(" #n ")" ::: "memory")
#define PG8_BAR __builtin_amdgcn_s_barrier()
#define PG8_SCHED __builtin_amdgcn_sched_barrier(0)
  Unit cur, nxt; int ui = 0;
  if (!S.next(0, cur)) return;
  f32x4 acc[2][2][4][2];
#pragma unroll
  for (int a = 0; a < 2; ++a)
#pragma unroll
    for (int b = 0; b < 2; ++b)
#pragma unroll
      for (int m = 0; m < 4; ++m)
#pragma unroll
        for (int n = 0; n < 2; ++n) acc[a][b][m][n] = (f32x4){0.f, 0.f, 0.f, 0.f};
  bf16x8 At[4][2], B0[2][2], B1[2][2];
  const char* cA = (const char*)g.A + (size_t)cur.pm * tstep; const char* cB = (const char*)g.Bt + (size_t)cur.pn * tstep;
  PG8_STAGE(PG8_SB(0, 0), cB, voffB); PG8_STAGE(PG8_SA(0, 0), cA, voffA); PG8_STAGE(PG8_SB(0, 1), cB + hstep, voffB); PG8_STAGE(PG8_SA(0, 1), cA + hstep, voffA);
  if (wr == 1) PG8_BAR;
  PG8_WAIT_V(4); PG8_BAR;
  PG8_STAGE(PG8_SB(1, 0), cB + kstep, voffB); PG8_STAGE(PG8_SA(1, 0), cA + kstep, voffA); PG8_STAGE(PG8_SB(1, 1), cB + hstep + kstep, voffB);
  PG8_WAIT_V(6); PG8_BAR;
  for (;;) {
    const bool has_next = S.next(ui + 1, nxt);
    const char* nA = has_next ? (const char*)g.A + (size_t)nxt.pm * tstep : cA; const char* nB = has_next ? (const char*)g.Bt + (size_t)nxt.pn * tstep : cB;
    for (int t = 0; t < nt; t += 2) {
      const bool last = (t == nt - 2);
      if (E.type == 2 && t == 16) E.hook(acc, cur, wr, wc, fr, fq);
      const char* a1 = cA + (size_t)(t + 1) * kstep;
      const char* a2 = last ? nA : cA + (size_t)(t + 2) * kstep; const char* b2 = last ? nB : cB + (size_t)(t + 2) * kstep;
      const char* a3 = a2 + kstep; const char* b3 = b2 + kstep;
      PG8_LDB(B0, 0, 0); PG8_SCHED; PG8_LDA(At, 0, 0); PG8_STAGE(PG8_SA(1, 1), a1 + hstep, voffA);
      PG8_WAIT_L(8); PG8_BAR; PG8_WAIT_L(0); PG8_MMA(0, 0, At, B0); PG8_BAR; PG8_SCHED;
      PG8_LDB(B1, 0, 1); PG8_STAGE(PG8_SB(0, 0), b2, voffB);
      PG8_BAR; PG8_WAIT_L(0); PG8_MMA(0, 1, At, B1); PG8_BAR;
      PG8_LDA(At, 0, 1); PG8_STAGE(PG8_SA(0, 0), a2, voffA);
      PG8_BAR; PG8_WAIT_L(0); PG8_MMA(1, 0, At, B0); PG8_BAR; PG8_SCHED;
      PG8_STAGE(PG8_SB(0, 1), b2 + hstep, voffB);
      PG8_WAIT_V(6); PG8_BAR; PG8_MMA(1, 1, At, B1); PG8_BAR;
      PG8_LDB(B0, 1, 0); PG8_SCHED; PG8_LDA(At, 1, 0); PG8_STAGE(PG8_SA(0, 1), a2 + hstep, voffA);
      PG8_WAIT_L(8); PG8_BAR; PG8_WAIT_L(0); PG8_MMA(0, 0, At, B0); PG8_BAR; PG8_SCHED;
      PG8_LDB(B1, 1, 1); PG8_STAGE(PG8_SB(1, 0), b3, voffB);
      PG8_BAR; PG8_WAIT_L(0); PG8_MMA(0, 1, At, B1); PG8_BAR;
      PG8_LDA(At, 1, 1); PG8_STAGE(PG8_SA(1, 0), a3, voffA);
      PG8_BAR; PG8_WAIT_L(0); PG8_MMA(1, 0, At, B0); PG8_BAR; PG8_SCHED;
      PG8_STAGE(PG8_SB(1, 1), b3 + hstep, voffB);
      PG8_WAIT_V(6); PG8_BAR; PG8_MMA(1, 1, At, B1); PG8_BAR;
    }
    E(acc, cur, wr, wc, fr, fq);
    if (!has_next) break;
#pragma unroll
    for (int a = 0; a < 2; ++a)
#pragma unroll
      for (int b = 0; b < 2; ++b)
#pragma unroll
        for (int m = 0; m < 4; ++m)
#pragma unroll
          for (int n = 0; n < 2; ++n) acc[a][b][m][n] = (f32x4){0.f, 0.f, 0.f, 0.f};
    cur = nxt; cA = nA; cB = nB; ++ui;
  }
  PG8_WAIT_V(0);
  if (wr == 0) PG8_BAR;
  PG8_BAR;
#undef PG8_SA
#undef PG8_SB
#undef PG8_STAGE
#undef PG8_LDA
#undef PG8_LDB
#undef PG8_MMA
#undef PG8_WAIT_V
#undef PG8_WAIT_L
#undef PG8_BAR
#undef PG8_SCHED
}
}
using pg8::Unit; using pg8::Gemm; using pg8::StaticOrder;
typedef f32x4 Acc[2][2][4][2];

struct EpiG1 {
  static constexpr bool PERM = true;
  unsigned char* ws; const float* lbs;
  __device__ __forceinline__ void operator()(const Acc& acc, const Unit& u, int wr, int wc, int fr, int fq) const {
    const int pn = u.pn, row0 = u.pm * 256 + wr * 64 + fr;
    if (pn >= 20 && pn < 24) {
      u16* UT = (u16*)(ws + WS_UT);
      const int part = (pn - 20) >> 1;
#pragma unroll
      for (int ai = 0; ai < 2; ++ai)
#pragma unroll
        for (int m = 0; m < 4; ++m) {
          const int r = row0 + ai * 128 + m * 16;
          size_t base; size_t chs;
          if (r < NPROMPT) { const int bp = r >> 8, l = r & 255; base = (size_t)bp * 512 * 512 + part * 256 + l; chs = 512; }
          else { const int rr = r - NPROMPT, b = rr >> 12, l = rr & 4095; base = UT_SAMPLE_OFF + (size_t)b * 512 * 8192 + part * 4096 + l; chs = 8192; }
#pragma unroll
          for (int bj = 0; bj < 2; ++bj) {
            const int ch0 = ((pn - 20) & 1) * 256 + bj * 128 + wc * 32 + 8 * fq;
#pragma unroll
            for (int n = 0; n < 2; ++n)
#pragma unroll
              for (int e = 0; e < 4; e += 2) { const unsigned pr = pk2(acc[ai][bj][m][n][e], acc[ai][bj][m][n][e + 1]);
                UT[base + (size_t)(ch0 + 4 * n + e) * chs] = (u16)(pr & 0xFFFFu); UT[base + (size_t)(ch0 + 4 * n + e + 1) * chs] = (u16)(pr >> 16); }
          }
        }
      return;
    }
    int act, ld = 1024, colt; size_t off;
    if (pn < 4) { act = 1; off = WS_Q; colt = pn * 256; }
    else if (pn < 8) { act = 3; off = WS_LF; colt = (pn - 4) * 256; }
    else if (pn < 12) { act = 4; off = WS_LB; colt = (pn - 8) * 256; }
    else if (pn < 16) { act = 0; off = WS_V; colt = (pn - 12) * 256; }
    else if (pn < 20) { act = 1; off = WS_ZA; colt = (pn - 16) * 256; }
    else if (pn < 26) { act = 1; off = WS_ZB; colt = (pn - 24) * 256; ld = 512; }
    else if (pn < 30) { act = 2; off = WS_GA; colt = (pn - 26) * 256; }
    else { act = 2; off = WS_GB; colt = (pn - 30) * 256; }
    u16* dst = (u16*)(ws + off);
    const int col0 = colt + wc * 32 + 8 * fq;
    f32x4 lbv[2][2];
    if (act >= 3) { const float* lb = lbs + (act == 4 ? 1024 : 0) + col0;
#pragma unroll
      for (int bj = 0; bj < 2; ++bj) { lbv[bj][0] = *(const f32x4*)(lb + bj * 128); lbv[bj][1] = *(const f32x4*)(lb + bj * 128 + 4); } }
#pragma unroll
    for (int ai = 0; ai < 2; ++ai)
#pragma unroll
      for (int m = 0; m < 4; ++m) {
        u16* rowp = dst + (size_t)(row0 + ai * 128 + m * 16) * ld + col0;
#pragma unroll
        for (int bj = 0; bj < 2; ++bj) {
          float v[8];
#pragma unroll
          for (int e = 0; e < 8; ++e) v[e] = acc[ai][bj][m][e >> 2][e & 3];
          u32x4 o;
          if (act >= 3) {
            unsigned short hv[8];
#pragma unroll
            for (int e = 0; e < 8; ++e) { const float oml = 1.f - lbv[bj][e >> 2][e & 3]; const float kk = oml * __builtin_amdgcn_rcpf(1.f + __expf(v[e])); hv[e] = f2h(fmaxf(__log2f(1.f - kk), -57.f)); }
            o[0] = hv[0] | ((unsigned)hv[1] << 16); o[1] = hv[2] | ((unsigned)hv[3] << 16); o[2] = hv[4] | ((unsigned)hv[5] << 16); o[3] = hv[6] | ((unsigned)hv[7] << 16);
          } else {
            if (act == 1) {
#pragma unroll
              for (int e = 0; e < 8; ++e) v[e] = siluf(v[e]);
            } else if (act == 2) {
#pragma unroll
              for (int e = 0; e < 8; ++e) v[e] = sigmf(v[e]);
            }
            o[0] = pk2(v[0], v[1]); o[1] = pk2(v[2], v[3]); o[2] = pk2(v[4], v[5]); o[3] = pk2(v[6], v[7]);
          }
          *(u32x4*)(rowp + bj * 128) = o;
        }
      }
  }
};
struct EpiDFT {
  static constexpr bool PERM = true;
  unsigned char* ws; int rowbase, lshift; float scale;
  __device__ __forceinline__ void operator()(const Acc& acc, const Unit& u, int wr, int wc, int fr, int fq) const {
    const u16* ZB = (const u16*)(ws + WS_ZB); u16* YB = (u16*)(ws + WS_YAB);
    const int k0 = u.pm * 256 + wr * 64 + fr;
    const int n0 = u.pn * 256 + wc * 32 + 8 * fq, b = n0 >> 9, ch0 = n0 & 511;
    const size_t R0 = (size_t)rowbase + ((size_t)b << lshift) + k0;
    const u16* zb = ZB + R0 * 512 + ch0; u16* yb = YB + R0 * 1536 + 1024 + ch0;
#pragma unroll
    for (int ai = 0; ai < 2; ++ai) {
      u32x4 z[4][2];
#pragma unroll
      for (int m = 0; m < 4; ++m)
#pragma unroll
        for (int bj = 0; bj < 2; ++bj) z[m][bj] = *(const u32x4*)(zb + (ai * 128 + m * 16) * 512 + bj * 128);
#pragma unroll
      for (int m = 0; m < 4; ++m)
#pragma unroll
        for (int bj = 0; bj < 2; ++bj) {
          const u32x4 zz = z[m][bj]; u32x4 o;
          o[0] = pk2(acc[ai][bj][m][0][0] * scale * bflo(zz[0]), acc[ai][bj][m][0][1] * scale * bfhi(zz[0]));
          o[1] = pk2(acc[ai][bj][m][0][2] * scale * bflo(zz[1]), acc[ai][bj][m][0][3] * scale * bfhi(zz[1]));
          o[2] = pk2(acc[ai][bj][m][1][0] * scale * bflo(zz[2]), acc[ai][bj][m][1][1] * scale * bfhi(zz[2]));
          o[3] = pk2(acc[ai][bj][m][1][2] * scale * bflo(zz[3]), acc[ai][bj][m][1][3] * scale * bfhi(zz[3]));
          *(u32x4*)(yb + (ai * 128 + m * 16) * 1536 + bj * 128) = o;
        }
      __builtin_amdgcn_sched_barrier(0);
    }
  }
};
struct EpiG2 {
  static constexpr bool PERM = false;
  unsigned char* ws;
  __device__ __forceinline__ void hook(Acc& acc, const Unit& u, int wr, int wc, int fr, int fq) const {
    const u16* GA = (const u16*)(ws + WS_GA); const u16* GB = (const u16*)(ws + WS_GB);
    const int row0 = u.pm * 256 + wr * 64 + fr, col0 = u.pn * 256 + wc * 32 + 4 * fq;
#pragma unroll
    for (int ai = 0; ai < 2; ++ai) {
      u32x2 ga[4][2][2], gb[4][2][2];
#pragma unroll
      for (int m = 0; m < 4; ++m)
#pragma unroll
        for (int bj = 0; bj < 2; ++bj)
#pragma unroll
          for (int n = 0; n < 2; ++n) { const size_t idx = (size_t)(row0 + ai * 128 + m * 16) * 1024 + col0 + bj * 128 + n * 16;
            ga[m][bj][n] = *(const u32x2*)(GA + idx); gb[m][bj][n] = *(const u32x2*)(GB + idx); }
#pragma unroll
      for (int m = 0; m < 4; ++m)
#pragma unroll
        for (int bj = 0; bj < 2; ++bj)
#pragma unroll
          for (int n = 0; n < 2; ++n) { const u32x2 a = ga[m][bj][n], b = gb[m][bj][n]; f32x4& v = acc[ai][bj][m][n];
            v[0] *= bflo(a[0]) * __builtin_amdgcn_rcpf(fmaxf(bflo(b[0]), 1e-30f)); v[1] *= bfhi(a[0]) * __builtin_amdgcn_rcpf(fmaxf(bfhi(b[0]), 1e-30f));
            v[2] *= bflo(a[1]) * __builtin_amdgcn_rcpf(fmaxf(bflo(b[1]), 1e-30f)); v[3] *= bfhi(a[1]) * __builtin_amdgcn_rcpf(fmaxf(bfhi(b[1]), 1e-30f)); }
      __builtin_amdgcn_sched_barrier(0);
    }
  }
  __device__ __forceinline__ void operator()(const Acc& acc, const Unit& u, int wr, int wc, int fr, int fq) const {
    const u16* GB = (const u16*)(ws + WS_GB); u16* MG = (u16*)(ws + WS_MERGED);
    const int row0 = u.pm * 256 + wr * 64 + fr, col0 = u.pn * 256 + wc * 32 + 4 * fq;
#pragma unroll
    for (int ai = 0; ai < 2; ++ai) {
      u32x2 gb[4][2][2];
#pragma unroll
      for (int m = 0; m < 4; ++m)
#pragma unroll
        for (int bj = 0; bj < 2; ++bj)
#pragma unroll
          for (int n = 0; n < 2; ++n) gb[m][bj][n] = *(const u32x2*)(GB + (size_t)(row0 + ai * 128 + m * 16) * 1024 + col0 + bj * 128 + n * 16);
#pragma unroll
      for (int m = 0; m < 4; ++m)
#pragma unroll
        for (int bj = 0; bj < 2; ++bj)
#pragma unroll
          for (int n = 0; n < 2; ++n) { const u32x2 b = gb[m][bj][n]; const f32x4 v = acc[ai][bj][m][n];
            u32x2 o; o[0] = pk2(v[0] * bflo(b[0]), v[1] * bfhi(b[0])); o[1] = pk2(v[2] * bflo(b[1]), v[3] * bfhi(b[1]));
            *(u32x2*)(MG + (size_t)(row0 + ai * 128 + m * 16) * 1024 + col0 + bj * 128 + n * 16) = o; }
      __builtin_amdgcn_sched_barrier(0);
    }
  }
};
struct EpiG3 {
  static constexpr bool PERM = false;
  float* x; const float* modl;
  __device__ __forceinline__ void operator()(const Acc& acc, const Unit& u, int wr, int wc, int fr, int fq) const {
    const int j = u.pm < 32 ? 0 : 1 + ((u.pm - 32) >> 4);
    const float* gt = modl + j * 3072 + 2048;
    const int row0 = u.pm * 256 + wr * 64 + fr, col0 = u.pn * 256 + wc * 32 + 4 * fq;
    f32x4 gv[2][2];
#pragma unroll
    for (int bj = 0; bj < 2; ++bj)
#pragma unroll
      for (int n = 0; n < 2; ++n) gv[bj][n] = *(const f32x4*)(gt + col0 + bj * 128 + n * 16);
#pragma unroll
    for (int ai = 0; ai < 2; ++ai)
#pragma unroll
      for (int mp = 0; mp < 2; ++mp) {
        f32x4 xv[2][2][2];
#pragma unroll
        for (int mi = 0; mi < 2; ++mi)
#pragma unroll
          for (int bj = 0; bj < 2; ++bj)
#pragma unroll
            for (int n = 0; n < 2; ++n) xv[mi][bj][n] = *(const f32x4*)(x + (size_t)(row0 + ai * 128 + (2 * mp + mi) * 16) * 1024 + col0 + bj * 128 + n * 16);
#pragma unroll
        for (int mi = 0; mi < 2; ++mi)
#pragma unroll
          for (int bj = 0; bj < 2; ++bj)
#pragma unroll
            for (int n = 0; n < 2; ++n) *(f32x4*)(x + (size_t)(row0 + ai * 128 + (2 * mp + mi) * 16) * 1024 + col0 + bj * 128 + n * 16) = xv[mi][bj][n] + gv[bj][n] * acc[ai][bj][2 * mp + mi][n];
        __builtin_amdgcn_sched_barrier(0);
      }
  }
};

__device__ __forceinline__ void p0_prologue(const P& p, unsigned char* shm, const int tid) {
  const int bid = blockIdx.x, G = gridDim.x;
  float* fs = (float*)shm;
  for (int i = bid * 512 + tid; i < 2048; i += G * 512) {
    float r[4], mx = -1e30f;
    for (int l = 0; l < 4; ++l) { r[l] = p.lb_raw[l * 2048 + i]; mx = fmaxf(mx, r[l]); }
    float s = 0.f; for (int l = 0; l < 4; ++l) { r[l] = expf(r[l] - mx); s += r[l]; }
    float cs = 0.f; float* lbs = (float*)(p.ws + WS_LBS);
    for (int l = 0; l < 4; ++l) { if (l > 0) cs += r[l] / s; lbs[l * 2048 + i] = cs; }
  }
  for (int it = bid; it < 96; it += G) {
    const int l = it / 24, n0 = (it % 24) * 128;
    for (int i = tid; i < 5120; i += 512) { const int j = i >> 10, k = i & 1023; const float cv = j == 0 ? p.c_ctx[k] : p.c[(j - 1) * 1024 + k]; fs[i] = cv / (1.f + expf(-cv)); }
    __syncthreads();
    const int col = tid & 127, kq = tid >> 7;
    float a[5] = {0.f, 0.f, 0.f, 0.f, 0.f};
    const float* w = p.w_ada + ((size_t)l * 1024 + kq * 256) * 3072 + n0 + col;
    for (int k = 0; k < 256; k += 32) {
      float wv[32];
#pragma unroll
      for (int u = 0; u < 32; ++u) wv[u] = w[(size_t)(k + u) * 3072];
#pragma unroll
      for (int u = 0; u < 32; ++u)
#pragma unroll
        for (int j = 0; j < 5; ++j) a[j] += fs[j * 1024 + kq * 256 + k + u] * wv[u];
    }
    __syncthreads();
#pragma unroll
    for (int j = 0; j < 5; ++j) fs[5120 + (kq * 5 + j) * 128 + col] = a[j];
    __syncthreads();
    if (tid < 128) {
      float* modv = (float*)(p.ws + WS_MOD);
#pragma unroll
      for (int j = 0; j < 5; ++j) { const float s = fs[5120 + (0 * 5 + j) * 128 + tid] + fs[5120 + (1 * 5 + j) * 128 + tid] + fs[5120 + (2 * 5 + j) * 128 + tid] + fs[5120 + (3 * 5 + j) * 128 + tid];
        modv[((size_t)l * 5 + j) * 3072 + n0 + tid] = s + p.b_ada[l * 3072 + n0 + tid]; }
    }
    __syncthreads();
  }
  for (int it = bid; it < 256; it += G) {
    const int l = it >> 6, g = (it >> 4) & 3, k0 = (it & 15) * 64;
    for (int i = tid; i < 64 * 32; i += 512) { const int kk = i >> 5, c4 = (i & 31) * 4;
      const f32x4 v = *(const f32x4*)(p.w_in + ((size_t)l * 1024 + k0 + kk) * DIN + 5120 + g * 128 + c4);
      fs[(c4 + 0) * 68 + kk] = v[0]; fs[(c4 + 1) * 68 + kk] = v[1]; fs[(c4 + 2) * 68 + kk] = v[2]; fs[(c4 + 3) * 68 + kk] = v[3]; }
    __syncthreads();
    const int m = tid & 127, kq = tid >> 7;
    float sm, cm; sincospif((float)m / 64.f, &sm, &cm);
    float cr = 1.f, sr = 0.f, ac[16], as[16];
#pragma unroll
    for (int i = 0; i < 16; ++i) { ac[i] = 0.f; as[i] = 0.f; }
    for (int c = 0; c < 128; ++c) {
      const float* wrow = fs + c * 68 + kq * 16;
#pragma unroll
      for (int i4 = 0; i4 < 4; ++i4) { const f32x4 wv = *(const f32x4*)(wrow + i4 * 4);
#pragma unroll
        for (int e = 0; e < 4; ++e) { ac[i4 * 4 + e] += wv[e] * cr; as[i4 * 4 + e] -= wv[e] * sr; } }
      const float c2 = cr * cm - sr * sm, s2 = sr * cm + cr * sm; cr = c2; sr = s2;
    }
    u16* WIN = (u16*)(p.ws + WS_WIN) + (size_t)l * NG1 * 1024;
    u32x4 o0, o1, o2, o3;
    o0[0] = pk2(ac[0], ac[1]); o0[1] = pk2(ac[2], ac[3]); o0[2] = pk2(ac[4], ac[5]); o0[3] = pk2(ac[6], ac[7]);
    o1[0] = pk2(ac[8], ac[9]); o1[1] = pk2(ac[10], ac[11]); o1[2] = pk2(ac[12], ac[13]); o1[3] = pk2(ac[14], ac[15]);
    o2[0] = pk2(as[0], as[1]); o2[1] = pk2(as[2], as[3]); o2[2] = pk2(as[4], as[5]); o2[3] = pk2(as[6], as[7]);
    o3[0] = pk2(as[8], as[9]); o3[1] = pk2(as[10], as[11]); o3[2] = pk2(as[12], as[13]); o3[3] = pk2(as[14], as[15]);
    u16* dc = WIN + (size_t)(5120 + g * 128 + m) * 1024 + k0 + kq * 16;
    u16* ds = WIN + (size_t)(5120 + 512 + g * 128 + m) * 1024 + k0 + kq * 16;
    *(u32x4*)dc = o0; *(u32x4*)(dc + 8) = o1; *(u32x4*)ds = o2; *(u32x4*)(ds + 8) = o3;
    __syncthreads();
  }
  {
    constexpr int I_IN = 16 * 120, I_PA = 16 * 16, I_PB = 8 * 16, I_O = 16 * 16, I_L = I_IN + I_PA + I_PB + I_O;
    for (int it0 = bid; it0 < 4 * I_L; it0 += 4 * G) {
#pragma unroll
      for (int q = 0; q < 4; ++q) {
        const int it = it0 + q * G; if (it >= 4 * I_L) break;
        const int l = it / I_L; int r = it % I_L;
        const float* W; int Nsrc, kb, nsrc0;
        if (r < I_IN) { kb = r / 120; const int nb = r % 120; nsrc0 = nb * 64 + (nb * 64 >= 5120 ? 512 : 0); W = p.w_in + (size_t)l * 1024 * DIN; Nsrc = DIN; }
        else if ((r -= I_IN) < I_PA) { kb = r / 16; nsrc0 = (r % 16) * 64; W = p.w_pa + (size_t)l * 1024 * 1024; Nsrc = 1024; }
        else if ((r -= I_PA) < I_PB) { kb = r / 16; nsrc0 = (r % 16) * 64; W = p.w_pb + (size_t)l * 512 * 1024; Nsrc = 1024; }
        else { r -= I_PB; kb = r / 16; nsrc0 = (r % 16) * 64; W = p.w_o + (size_t)l * 1024 * 1024; Nsrc = 1024; }
        const int k0 = kb * 64;
#pragma unroll
        for (int ps = 0; ps < 8; ++ps) { const int kk = ps * 8 + (tid >> 6), nn = tid & 63; fs[q * 4160 + kk * 65 + nn] = W[(size_t)(k0 + kk) * Nsrc + nsrc0 + nn]; }
      }
      __syncthreads();
#pragma unroll
      for (int q = 0; q < 4; ++q) {
        const int it = it0 + q * G; if (it >= 4 * I_L) break;
        const int l = it / I_L; int r = it % I_L;
        u16* WT; int Kd, kb, ndst0;
        if (r < I_IN) { kb = r / 120; const int nb = r % 120; ndst0 = nb * 64; if (ndst0 >= 5120) ndst0 += 1024; WT = (u16*)(p.ws + WS_WIN) + (size_t)l * NG1 * 1024; Kd = 1024; }
        else if ((r -= I_IN) < I_PA) { kb = r / 16; ndst0 = (r % 16) * 64; WT = (u16*)(p.ws + WS_WPA) + (size_t)l * 1024 * 1536; Kd = 1536; }
        else if ((r -= I_PA) < I_PB) { kb = r / 16; ndst0 = (r % 16) * 64; WT = (u16*)(p.ws + WS_WPA) + (size_t)l * 1024 * 1536 + 1024; Kd = 1536; }
        else { r -= I_PB; kb = r / 16; ndst0 = (r % 16) * 64; WT = (u16*)(p.ws + WS_WO) + (size_t)l * 1024 * 1024; Kd = 1024; }
        const int k0 = kb * 64;
        const int nn = tid >> 3, kc = tid & 7; const float* sp = fs + q * 4160 + (8 * kc) * 65 + nn;
        u32x4 o; o[0] = pk2(sp[0], sp[65]); o[1] = pk2(sp[2 * 65], sp[3 * 65]); o[2] = pk2(sp[4 * 65], sp[5 * 65]); o[3] = pk2(sp[6 * 65], sp[7 * 65]);
        *(u32x4*)(WT + (size_t)(ndst0 + nn) * Kd + k0 + 8 * kc) = o;
      }
      __syncthreads();
    }
  }
  {
    __syncthreads();
    for (int r = tid; r < 4096; r += 512) { float sv, cv; sincospif((float)r * (1.f / 2048.f), &sv, &cv); fs[r] = cv; fs[4096 + r] = sv; }
    __syncthreads();
    u16* DS = (u16*)(p.ws + WS_DFTS);
    for (size_t i = (size_t)bid * 512 + tid; i < (size_t)4096 * 512; i += (size_t)G * 512) {
      const int k = (int)(i >> 9), j0 = (int)(i & 511) * 8; const int part = j0 >> 11, jj = j0 & 2047;
      const float* tb = fs + part * 4096;
      float v[8];
#pragma unroll
      for (int e = 0; e < 8; ++e) v[e] = tb[(k * (jj + e)) & 4095];
      if (part == 1 && jj == 0) v[0] = (k & 1) ? -1.f : 1.f;
      u32x4 o; o[0] = pk2(v[0], v[1]); o[1] = pk2(v[2], v[3]); o[2] = pk2(v[4], v[5]); o[3] = pk2(v[6], v[7]);
      *(u32x4*)(DS + (size_t)k * 4096 + j0) = o;
    }
    u16* DP = (u16*)(p.ws + WS_DFTP);
    for (int i = bid * 512 + tid; i < 256 * 64; i += G * 512) {
      const int k = i >> 6, j0 = (i & 63) * 8; const int part = j0 >> 8, jj = j0 & 255;
      const float* tb = fs + part * 4096;
      float v[8];
#pragma unroll
      for (int e = 0; e < 8; ++e) v[e] = tb[((k * (jj + e)) & 255) * 16];
      u32x4 o; o[0] = pk2(v[0], v[1]); o[1] = pk2(v[2], v[3]); o[2] = pk2(v[4], v[5]); o[3] = pk2(v[6], v[7]);
      *(u32x4*)(DP + (size_t)k * 512 + j0) = o;
    }
  }
}

__device__ __forceinline__ void phase_fold(const P& p, const int tid) {
  const u16* UT = (const u16*)(p.ws + WS_UT) + UT_SAMPLE_OFF; u16* UF = (u16*)(p.ws + WS_H);
  for (int it = blockIdx.x * 512 + tid; it < 2048 * 512; it += gridDim.x * 512) {
    const int n = it >> 9, c = it & 511, part = c >> 8, cc = c & 255;
    const u16* base = UT + (size_t)n * 8192 + part * 4096;
    const u32x4 f = *(const u32x4*)(base + 8 * cc), g = *(const u32x4*)(base + 4096 - 8 * cc - 8);
    float fw[8], bw[8];
#pragma unroll
    for (int e = 0; e < 4; ++e) { fw[2 * e] = bflo(f[e]); fw[2 * e + 1] = bfhi(f[e]); }
    float gv[8];
#pragma unroll
    for (int e = 0; e < 4; ++e) { gv[2 * e] = bflo(g[e]); gv[2 * e + 1] = bfhi(g[e]); }
#pragma unroll
    for (int e = 1; e < 8; ++e) bw[e] = gv[8 - e];
    bw[0] = cc ? bf2f(base[4096 - 8 * cc]) : 0.f;
    float o[8];
#pragma unroll
    for (int e = 0; e < 8; ++e) o[e] = part ? fw[e] - bw[e] : fw[e] + bw[e];
    if (cc == 0) o[0] = part ? bf2f(UT[(size_t)n * 8192 + 2048]) : fw[0];
    u32x4 ov; ov[0] = pk2(o[0], o[1]); ov[1] = pk2(o[2], o[3]); ov[2] = pk2(o[4], o[5]); ov[3] = pk2(o[6], o[7]);
    *(u32x4*)(UF + (size_t)n * 4096 + part * 2048 + 8 * cc) = ov;
  }
}

__device__ __forceinline__ void phase_h(const P& p, int l, bool first, const int tid) {
  const int lane = tid & 63, gw = blockIdx.x * 8 + (tid >> 6), ngw = gridDim.x * 8;
  const float* modl = (const float*)(p.ws + WS_MOD) + (size_t)l * 5 * 3072;
  u16* H = (u16*)(p.ws + WS_H);
  float pef[4] = {0.f, 0.f, 0.f, 0.f};
  if (first) {
#pragma unroll
    for (int e = 0; e < 4; ++e) pef[e] = 1.0f / powf(10000.0f, (float)(4 * lane + e) / 256.0f);
  }
  for (int r = gw; r < NTOK; r += ngw) {
    const int j = r < NPROMPT ? 0 : 1 + ((r - NPROMPT) >> 12);
    float* xr = p.out + (size_t)r * 1024;
    f32x4 v[4];
    if (first) {
      const float* src = r < NPROMPT ? p.x_prompt + (size_t)r * 1024 : p.x_sample + (size_t)(r - NPROMPT) * 1024;
#pragma unroll
      for (int i = 0; i < 4; ++i) v[i] = *(const f32x4*)(src + 4 * (lane + 64 * i));
      if (r >= NPROMPT) {
        const int pos = (r - NPROMPT) & 4095; const float pr = (float)(pos >> 6), pc = (float)(pos & 63);
#pragma unroll
        for (int e = 0; e < 4; ++e) {
          const float fr_ = pef[e];
          v[0][e] += sinf(pr * fr_); v[1][e] += cosf(pr * fr_); v[2][e] += sinf(pc * fr_); v[3][e] += cosf(pc * fr_);
        }
      }
#pragma unroll
      for (int i = 0; i < 4; ++i) *(f32x4*)(xr + 4 * (lane + 64 * i)) = v[i];
    } else {
#pragma unroll
      for (int i = 0; i < 4; ++i) v[i] = *(const f32x4*)(xr + 4 * (lane + 64 * i));
    }
    float ss = 0.f;
#pragma unroll
    for (int i = 0; i < 4; ++i) ss += (v[i][0] * v[i][0] + v[i][1] * v[i][1]) + (v[i][2] * v[i][2] + v[i][3] * v[i][3]);
    const float rstd = rsqrtf(wave_sum(ss) * (1.f / 1024.f) + 1e-6f);
#pragma unroll
    for (int i = 0; i < 4; ++i) {
      const int e0 = 4 * (lane + 64 * i);
      const f32x4 nw = *(const f32x4*)(p.norm_w + l * 1024 + e0), sh = *(const f32x4*)(modl + j * 3072 + e0), sc = *(const f32x4*)(modl + j * 3072 + 1024 + e0);
      f32x4 hh;
#pragma unroll
      for (int e = 0; e < 4; ++e) hh[e] = (v[i][e] * rstd) * nw[e] * (1.f + sc[e]) + sh[e];
      u32x2 o; o[0] = pk2(hh[0], hh[1]); o[1] = pk2(hh[2], hh[3]);
      *(u32x2*)(H + (size_t)r * 1024 + e0) = o;
    }
  }
}

constexpr int SC_QB = 0, SC_KB = 8704, SC_KLT = 17408, SC_DEC = 26624, SC_EM = 27136, SC_BUF = 27648;
__device__ __forceinline__ float ex2(float x) { return __builtin_amdgcn_exp2f(x); }
__device__ __forceinline__ void scan_chain(const P& p, int l, int seq, int hh, int dir, int mode, int seg, unsigned char* shm, int& parity, const int tid) {
  const int w = tid >> 6, lane = tid & 63, fr = lane & 15, fq = lane >> 4;
  const bool samp = seq >= 32;
  const int L = samp ? 4096 : 256, rowbase = samp ? NPROMPT + (seq - 32) * 4096 : seq * 256, nch = mode ? 32 : (L >> 5), n0 = mode ? seg * 32 : 0;
  const int chain = (seq - 32) * 16 + hh * 2 + dir;
  const __amdgpu_buffer_rsrc_t rQ = __builtin_amdgcn_make_buffer_rsrc((void*)(p.ws + WS_Q), 0, 48 << 20, 0x00020000);
  const __amdgpu_buffer_rsrc_t rL = __builtin_amdgcn_make_buffer_rsrc((void*)(p.ws + (dir ? WS_LB : WS_LF)), 0, 48 << 20, 0x00020000);
  const __amdgpu_buffer_rsrc_t rV = __builtin_amdgcn_make_buffer_rsrc((void*)(p.ws + WS_V), 0, 48 << 20, 0x00020000);
  const __amdgpu_buffer_rsrc_t rO = __builtin_amdgcn_make_buffer_rsrc((void*)(p.ws + (dir ? WS_OB : WS_OF)), 0, 48 << 20, 0x00020000);
  unsigned sck = (unsigned)(((rowbase + (dir ? L - 32 * (n0 + 1) : 32 * n0)) * 1024 + hh * 128) * 2);
  const int sstep = dir ? -65536 : 65536;
  const unsigned vo_t = (unsigned)(((dir ? 24 - fq * 8 : fq * 8) * 1024 + w * 16 + fr) * 2);
  const unsigned vo_c = (unsigned)(((dir ? 15 - fr : fr) * 1024 + w * 16 + fq * 4) * 2);
  const unsigned vo_v = (unsigned)(((dir ? 12 - fq * 4 : fq * 4) * 1024 + w * 16 + fr) * 2);
#define SC_U(c, cmax) ((unsigned)(dir ? (cmax) - (c) : (c)))
  f32x4 S[8];
  if (mode == 1 || !samp) {
#pragma unroll
    for (int cb = 0; cb < 8; ++cb) S[cb] = (f32x4){0.f, 0.f, 0.f, 0.f};
  } else {
    const float* s0 = p.state + ((((size_t)(seq - 32) * 4 + l) * 2 + dir) * 8 + hh) * 16384 + w * 16 + fr;
#pragma unroll
    for (int cb = 0; cb < 8; ++cb)
#pragma unroll
      for (int j = 0; j < 4; ++j) S[cb][j] = s0[(cb * 16 + fq * 4 + j) * 128];
    for (int g = 0; g < seg; ++g) {
      const float* sl = (const float*)(p.ws + WS_SLOC) + ((size_t)chain * 3 + g) * 16384 + w * 16 + fr;
      const float* lg = (const float*)(p.ws + WS_LSEG) + ((size_t)chain * 3 + g) * 128 + fq * 4;
#pragma unroll
      for (int cb = 0; cb < 8; ++cb) { const f32x4 lv4 = *(const f32x4*)(lg + cb * 16);
#pragma unroll
        for (int j = 0; j < 4; ++j) S[cb][j] = ex2(lv4[j]) * S[cb][j] + sl[(cb * 16 + fq * 4 + j) * 128]; }
    }
  }
  f32x4 lsum = {0.f, 0.f, 0.f, 0.f};
  bf16x8 Lm[2];
#pragma unroll
  for (int tb = 0; tb < 2; ++tb)
#pragma unroll
    for (int j = 0; j < 8; ++j) Lm[tb][j] = (fq * 8 + j <= tb * 16 + fr) ? (short)0x3F80 : (short)0;
  u16 n_lft[8], n_v[8]; u32x2 n_lfc[2], n_qc[2] = {{0u, 0u}, {0u, 0u}};
#define SC_LOAD(SO) do { \
    _Pragma("unroll") for (int j = 0; j < 8; ++j) n_lft[j] = __builtin_amdgcn_raw_buffer_load_b16(rL, vo_t, (SO) + SC_U(j, 7) * 2048u, 0); \
    _Pragma("unroll") for (int tb = 0; tb < 2; ++tb) { n_lfc[tb] = __builtin_amdgcn_raw_buffer_load_b64(rL, vo_c, (SO) + SC_U(tb, 1) * 32768u, 0); \
      if (mode != 1) n_qc[tb] = __builtin_amdgcn_raw_buffer_load_b64(rQ, vo_c, (SO) + SC_U(tb, 1) * 32768u, 0); } \
    _Pragma("unroll") for (int i = 0; i < 8; ++i) n_v[i] = __builtin_amdgcn_raw_buffer_load_b16(rV, vo_v, (SO) + (SC_U(i >> 2, 1) * 16u + SC_U(i & 3, 3)) * 2048u, 0); } while (0)
  SC_LOAD(sck);
  for (int n = 0; n < nch; ++n) {
    u16 lft[8], vv[8]; u32x2 lfc[2], qc[2];
#pragma unroll
    for (int j = 0; j < 8; ++j) { lft[j] = n_lft[j]; vv[j] = n_v[j]; }
    lfc[0] = n_lfc[0]; lfc[1] = n_lfc[1]; qc[0] = n_qc[0]; qc[1] = n_qc[1];
    const unsigned scur = sck;
    sck = (unsigned)((int)sck + sstep);
    if (n + 1 < nch) SC_LOAD(sck);
    unsigned char* buf = shm + (parity & 1) * SC_BUF; parity ^= 1;
    bf16x8 ahi, alo, vop;
    {
      unsigned hb[8], lb2[8];
#pragma unroll
      for (int j = 0; j < 8; ++j) { const float x = h2f(lft[j]); const unsigned xb = __float_as_uint(x) & 0xFFFF0000u; hb[j] = xb; lb2[j] = __float_as_uint(x - __uint_as_float(xb)); }
      u32x4 ph, pl, pv;
#pragma unroll
      for (int j = 0; j < 4; ++j) { ph[j] = (hb[2 * j] >> 16) | hb[2 * j + 1]; pl[j] = (lb2[2 * j] >> 16) | (lb2[2 * j + 1] & 0xFFFF0000u); pv[j] = (unsigned)vv[2 * j] | ((unsigned)vv[2 * j + 1] << 16); }
      ahi = __builtin_bit_cast(bf16x8, ph); alo = __builtin_bit_cast(bf16x8, pl); vop = __builtin_bit_cast(bf16x8, pv);
    }
    f32x4 b[2];
#pragma unroll
    for (int tb = 0; tb < 2; ++tb) {
      b[tb] = __builtin_amdgcn_mfma_f32_16x16x32_bf16(ahi, Lm[tb], (f32x4){0.f, 0.f, 0.f, 0.f}, 0, 0, 0);
      b[tb] = __builtin_amdgcn_mfma_f32_16x16x32_bf16(alo, Lm[tb], b[tb], 0, 0, 0);
    }
    f32x4 blast, bmid, elm;
#pragma unroll
    for (int j = 0; j < 4; ++j) { blast[j] = __shfl(b[1][j], (lane & 48) | 15); bmid[j] = __shfl(b[0][j], (lane & 48) | 15); elm[j] = ex2(blast[j] - bmid[j]); }
    lsum += blast;
#pragma unroll
    for (int tb = 0; tb < 2; ++tb) {
      float qv[4], lv[4], qb[4], kb[4], kl[4];
      qv[0] = bflo(qc[tb][0]); qv[1] = bfhi(qc[tb][0]); qv[2] = bflo(qc[tb][1]); qv[3] = bfhi(qc[tb][1]);
      lv[0] = h2f((u16)(lfc[tb][0] & 0xFFFF)); lv[1] = h2f((u16)(lfc[tb][0] >> 16)); lv[2] = h2f((u16)(lfc[tb][1] & 0xFFFF)); lv[3] = h2f((u16)(lfc[tb][1] >> 16));
#pragma unroll
      for (int j = 0; j < 4; ++j) { const float kk = 1.f - ex2(lv[j]), d = b[tb][j] - bmid[j]; qb[j] = qv[j] * ex2(d); kb[j] = kk * ex2(-d); kl[j] = kb[j] * elm[j]; }
      if (mode != 1) {
        u32x2 o; o[0] = pk2(qb[0], qb[1]); o[1] = pk2(qb[2], qb[3]);
        *(u32x2*)(buf + SC_QB + (tb * 16 + fr) * 272 + (w * 16 + fq * 4) * 2) = o;
        o[0] = pk2(kb[0], kb[1]); o[1] = pk2(kb[2], kb[3]);
        *(u32x2*)(buf + SC_KB + (tb * 16 + fr) * 272 + (w * 16 + fq * 4) * 2) = o;
      }
      const unsigned k01 = pk2(kl[0], kl[1]), k23 = pk2(kl[2], kl[3]);
      unsigned char* kp = buf + SC_KLT + (w * 16 + fq * 4) * 72 + (tb * 16 + fr) * 2;
      *(u16*)(kp) = (u16)(k01 & 0xFFFFu); *(u16*)(kp + 72) = (u16)(k01 >> 16); *(u16*)(kp + 144) = (u16)(k23 & 0xFFFFu); *(u16*)(kp + 216) = (u16)(k23 >> 16);
    }
    if (fr == 0) { f32x4 d, em;
#pragma unroll
      for (int j = 0; j < 4; ++j) { em[j] = ex2(bmid[j]); d[j] = em[j] * elm[j]; }
      *(f32x4*)(buf + SC_DEC + (w * 16 + fq * 4) * 4) = d; *(f32x4*)(buf + SC_EM + (w * 16 + fq * 4) * 4) = em; }
    __syncthreads();
    if (mode != 1) {
    f32x4 at00 = {0.f, 0.f, 0.f, 0.f}, at01 = at00, at11 = at00;
#pragma unroll
    for (int kbk = 0; kbk < 4; ++kbk) {
      const bf16x8 k0 = *(const bf16x8*)(buf + SC_KB + fr * 272 + kbk * 64 + fq * 16), k1 = *(const bf16x8*)(buf + SC_KB + (16 + fr) * 272 + kbk * 64 + fq * 16);
      const bf16x8 q0 = *(const bf16x8*)(buf + SC_QB + fr * 272 + kbk * 64 + fq * 16), q1 = *(const bf16x8*)(buf + SC_QB + (16 + fr) * 272 + kbk * 64 + fq * 16);
      at00 = __builtin_amdgcn_mfma_f32_16x16x32_bf16(k0, q0, at00, 0, 0, 0);
      at01 = __builtin_amdgcn_mfma_f32_16x16x32_bf16(k0, q1, at01, 0, 0, 0);
      at11 = __builtin_amdgcn_mfma_f32_16x16x32_bf16(k1, q1, at11, 0, 0, 0);
    }
    bf16x8 p0, p1;
    {
      float a0[4], a2[4];
#pragma unroll
      for (int j = 0; j < 4; ++j) { const int sl = fq * 4 + j; a0[j] = sl <= fr ? at00[j] : 0.f; a2[j] = sl <= fr ? at11[j] : 0.f; }
      u32x4 pp; pp[0] = pk2(a0[0], a0[1]); pp[1] = pk2(a0[2], a0[3]); pp[2] = 0u; pp[3] = 0u; p0 = __builtin_bit_cast(bf16x8, pp);
      pp[0] = pk2(at01[0], at01[1]); pp[1] = pk2(at01[2], at01[3]); pp[2] = pk2(a2[0], a2[1]); pp[3] = pk2(a2[2], a2[3]); p1 = __builtin_bit_cast(bf16x8, pp);
    }
    f32x4 o0 = __builtin_amdgcn_mfma_f32_16x16x32_bf16(p0, vop, (f32x4){0.f, 0.f, 0.f, 0.f}, 0, 0, 0);
    f32x4 o1 = __builtin_amdgcn_mfma_f32_16x16x32_bf16(p1, vop, (f32x4){0.f, 0.f, 0.f, 0.f}, 0, 0, 0);
#pragma unroll
    for (int kbk = 0; kbk < 4; ++kbk) {
      const f32x4 e0v = *(const f32x4*)(buf + SC_EM + (2 * kbk * 16 + fq * 4) * 4), e1v = *(const f32x4*)(buf + SC_EM + ((2 * kbk + 1) * 16 + fq * 4) * 4);
      const f32x4 s0 = S[2 * kbk] * e0v, s1 = S[2 * kbk + 1] * e1v;
      u32x4 sp; sp[0] = pk2(s0[0], s0[1]); sp[1] = pk2(s0[2], s0[3]); sp[2] = pk2(s1[0], s1[1]); sp[3] = pk2(s1[2], s1[3]);
      const bf16x8 sop = __builtin_bit_cast(bf16x8, sp);
      u32x4 qa, qb2;
      { const u32x2 x0 = *(const u32x2*)(buf + SC_QB + fr * 272 + kbk * 64 + fq * 8), x1 = *(const u32x2*)(buf + SC_QB + fr * 272 + kbk * 64 + 32 + fq * 8); qa[0] = x0[0]; qa[1] = x0[1]; qa[2] = x1[0]; qa[3] = x1[1]; }
      { const u32x2 x0 = *(const u32x2*)(buf + SC_QB + (16 + fr) * 272 + kbk * 64 + fq * 8), x1 = *(const u32x2*)(buf + SC_QB + (16 + fr) * 272 + kbk * 64 + 32 + fq * 8); qb2[0] = x0[0]; qb2[1] = x0[1]; qb2[2] = x1[0]; qb2[3] = x1[1]; }
      o0 = __builtin_amdgcn_mfma_f32_16x16x32_bf16(__builtin_bit_cast(bf16x8, qa), sop, o0, 0, 0, 0);
      o1 = __builtin_amdgcn_mfma_f32_16x16x32_bf16(__builtin_bit_cast(bf16x8, qb2), sop, o1, 0, 0, 0);
    }
#pragma unroll
    for (int j = 0; j < 4; j += 2) { const unsigned a = pk2(o0[j], o0[j + 1]), b = pk2(o1[j], o1[j + 1]);
      __builtin_amdgcn_raw_buffer_store_b16((u16)(a & 0xFFFFu), rO, vo_v, scur + (SC_U(0, 1) * 16u + SC_U(j, 3)) * 2048u, 0);
      __builtin_amdgcn_raw_buffer_store_b16((u16)(a >> 16), rO, vo_v, scur + (SC_U(0, 1) * 16u + SC_U(j + 1, 3)) * 2048u, 0);
      __builtin_amdgcn_raw_buffer_store_b16((u16)(b & 0xFFFFu), rO, vo_v, scur + (SC_U(1, 1) * 16u + SC_U(j, 3)) * 2048u, 0);
      __builtin_amdgcn_raw_buffer_store_b16((u16)(b >> 16), rO, vo_v, scur + (SC_U(1, 1) * 16u + SC_U(j + 1, 3)) * 2048u, 0); }
    }
#pragma unroll
    for (int cb = 0; cb < 8; ++cb) {
      const f32x4 d = *(const f32x4*)(buf + SC_DEC + (cb * 16 + fq * 4) * 4);
      u32x4 ka; { const u32x2 x0 = *(const u32x2*)(buf + SC_KLT + (cb * 16 + fr) * 72 + fq * 8), x1 = *(const u32x2*)(buf + SC_KLT + (cb * 16 + fr) * 72 + 32 + fq * 8); ka[0] = x0[0]; ka[1] = x0[1]; ka[2] = x1[0]; ka[3] = x1[1]; }
      S[cb] = __builtin_amdgcn_mfma_f32_16x16x32_bf16(__builtin_bit_cast(bf16x8, ka), vop, d * S[cb], 0, 0, 0);
    }
  }
#undef SC_LOAD
#undef SC_U
  if (mode == 1) {
    float* sl = (float*)(p.ws + WS_SLOC) + ((size_t)chain * 3 + seg) * 16384 + w * 16 + fr;
#pragma unroll
    for (int cb = 0; cb < 8; ++cb)
#pragma unroll
      for (int j = 0; j < 4; ++j) sl[(cb * 16 + fq * 4 + j) * 128] = S[cb][j];
    if (fr == 0) *(f32x4*)((float*)(p.ws + WS_LSEG) + ((size_t)chain * 3 + seg) * 128 + w * 16 + fq * 4) = lsum;
  }
  if (!samp) {
    float* ns = p.out + (size_t)NTOK * 1024 + ((((size_t)seq * 4 + l) * 2 + dir) * 8 + hh) * 16384 + w * 16 + fr;
#pragma unroll
    for (int cb = 0; cb < 8; ++cb)
#pragma unroll
      for (int j = 0; j < 4; ++j) ns[(cb * 16 + fq * 4 + j) * 128] = S[cb][j];
  }
}

__device__ __forceinline__ void phase_fin(const P& p, int l, const int tid) {
  const int lane = tid & 63, gw = blockIdx.x * 8 + (tid >> 6), ngw = gridDim.x * 8;
  const u16* OF = (const u16*)(p.ws + WS_OF); const u16* OB = (const u16*)(p.ws + WS_OB);
  const u16* ZA = (const u16*)(p.ws + WS_ZA); u16* YA = (u16*)(p.ws + WS_YAB);
  const float* gw_ = p.gnorm_w + l * 1024 + lane * 16;
  for (int r = gw; r < NTOK; r += ngw) {
    const size_t base = (size_t)r * 1024 + lane * 16;
    const u32x4 f0 = *(const u32x4*)(OF + base), f1 = *(const u32x4*)(OF + base + 8), b0 = *(const u32x4*)(OB + base), b1 = *(const u32x4*)(OB + base + 8);
    f32x4 o[4]; float ss = 0.f;
#pragma unroll
    for (int i = 0; i < 2; ++i) {
      o[i][0] = bflo(f0[2 * i]) + bflo(b0[2 * i]); o[i][1] = bfhi(f0[2 * i]) + bfhi(b0[2 * i]); o[i][2] = bflo(f0[2 * i + 1]) + bflo(b0[2 * i + 1]); o[i][3] = bfhi(f0[2 * i + 1]) + bfhi(b0[2 * i + 1]);
      o[2 + i][0] = bflo(f1[2 * i]) + bflo(b1[2 * i]); o[2 + i][1] = bfhi(f1[2 * i]) + bfhi(b1[2 * i]); o[2 + i][2] = bflo(f1[2 * i + 1]) + bflo(b1[2 * i + 1]); o[2 + i][3] = bfhi(f1[2 * i + 1]) + bfhi(b1[2 * i + 1]); }
#pragma unroll
    for (int i = 0; i < 4; ++i) ss += (o[i][0] * o[i][0] + o[i][1] * o[i][1]) + (o[i][2] * o[i][2] + o[i][3] * o[i][3]);
    ss += __shfl_xor(ss, 1); ss += __shfl_xor(ss, 2); ss += __shfl_xor(ss, 4);
    const float rstd = rsqrtf(ss * (1.f / 128.f) + 1e-6f);
    const u32x4 z0 = *(const u32x4*)(ZA + base), z1 = *(const u32x4*)(ZA + base + 8);
    float zf[16];
#pragma unroll
    for (int i = 0; i < 4; ++i) { zf[2 * i] = bflo(z0[i]); zf[2 * i + 1] = bfhi(z0[i]); zf[8 + 2 * i] = bflo(z1[i]); zf[8 + 2 * i + 1] = bfhi(z1[i]); }
    float y[16];
#pragma unroll
    for (int i = 0; i < 4; ++i) { const f32x4 g = *(const f32x4*)(gw_ + 4 * i);
#pragma unroll
      for (int e = 0; e < 4; ++e) y[4 * i + e] = o[i][e] * rstd * g[e] * zf[4 * i + e]; }
    u32x4 a, b2;
    a[0] = pk2(y[0], y[1]); a[1] = pk2(y[2], y[3]); a[2] = pk2(y[4], y[5]); a[3] = pk2(y[6], y[7]);
    b2[0] = pk2(y[8], y[9]); b2[1] = pk2(y[10], y[11]); b2[2] = pk2(y[12], y[13]); b2[3] = pk2(y[14], y[15]);
    *(u32x4*)(YA + (size_t)r * 1536 + lane * 16) = a; *(u32x4*)(YA + (size_t)r * 1536 + lane * 16 + 8) = b2;
  }
}

__device__ __forceinline__ void phase_final(const P& p, const int tid) {
  const int lane = tid & 63, gw = blockIdx.x * 8 + (tid >> 6), ngw = gridDim.x * 8;
  for (int r = gw; r < NTOK; r += ngw) {
    float* xr = p.out + (size_t)r * 1024;
    f32x4 v[4]; float ss = 0.f;
#pragma unroll
    for (int i = 0; i < 4; ++i) { v[i] = *(const f32x4*)(xr + 4 * (lane + 64 * i)); ss += (v[i][0] * v[i][0] + v[i][1] * v[i][1]) + (v[i][2] * v[i][2] + v[i][3] * v[i][3]); }
    const float rstd = rsqrtf(wave_sum(ss) * (1.f / 1024.f) + 1e-6f);
#pragma unroll
    for (int i = 0; i < 4; ++i) { const f32x4 fw = *(const f32x4*)(p.final_w + 4 * (lane + 64 * i)); *(f32x4*)(xr + 4 * (lane + 64 * i)) = v[i] * rstd * fw; }
  }
}

#define XB_TMO      128
#define XB_XCNT(j)  (256  + 64 * (j))
#define XB_XSUB(j)  (1280 + 64 * (j))
#define XB_XGEN(j)  (2304 + 64 * (j))
#define XB_TOP      3328
#define XB_TOPGEN   3392
#define XCD_BAR_WORDS 3456
#define XB_SPIN_CAP (1u << 18)
__device__ __forceinline__ unsigned xb_ld(unsigned* p)              { return __hip_atomic_load(p, __ATOMIC_RELAXED, __HIP_MEMORY_SCOPE_AGENT); }
__device__ __forceinline__ unsigned xb_add(unsigned* p, unsigned v) { return __hip_atomic_fetch_add(p, v, __ATOMIC_RELAXED, __HIP_MEMORY_SCOPE_AGENT); }
__device__ __forceinline__ unsigned xb_xcc_id() { return (unsigned)__builtin_amdgcn_s_getreg((3 << 11) | 20) & 0xFu; }
#define XB_SPIN(cond, bar) do { unsigned _sp = 0; while (cond) { __builtin_amdgcn_s_sleep(1); \
    if ((++_sp & 255u) == 0u) { if (xb_ld(&(bar)[XB_TMO])) break; if (_sp > XB_SPIN_CAP) { atomicAdd(&(bar)[XB_TMO], 1u); break; } } } } while (0)
__device__ __forceinline__ void xcd_barrier_complete(unsigned* bar, unsigned x, unsigned& nloc, unsigned& nx) {
    const unsigned G = gridDim.x * gridDim.y * gridDim.z;
    unsigned sum, cnt, mine, sp = 0u;
    for (;;) {
        sum = 0u; cnt = 0u; mine = 0u;
#pragma unroll
        for (unsigned j = 0; j < 16; ++j) { const unsigned c = xb_ld(&bar[XB_XCNT(j)]); sum += c; cnt += (c > 0u) ? 1u : 0u; mine = (j == x) ? c : mine; }
        if (sum == G) break;
        __builtin_amdgcn_s_sleep(1);
        if ((++sp & 255u) == 0u) { if (xb_ld(&bar[XB_TMO])) break; if (sp > XB_SPIN_CAP) { atomicAdd(&bar[XB_TMO], 1u); break; } }
    }
    nloc = mine > 0u ? mine : 1u; nx = cnt > 0u ? cnt : 1u;
}
__device__ __forceinline__ void xcd_barrier(unsigned* bar, volatile LAS unsigned* st, const int tid) {
    asm volatile("s_waitcnt vmcnt(0)" ::: "memory");
    __syncthreads();
    if (tid == 0) {
        const unsigned x = xb_xcc_id();
        __builtin_amdgcn_s_waitcnt(0);
        unsigned nloc = st[0], nx = st[1];
        if (nloc == 0u) { xcd_barrier_complete(bar, x, nloc, nx); st[0] = nloc; st[1] = nx; }
        const unsigned old = xb_add(&bar[XB_XSUB(x)], 1u);
        const unsigned gen = old / nloc;
        if (old + 1u == (gen + 1u) * nloc) {
            __builtin_amdgcn_fence(__ATOMIC_RELEASE, "agent");
            asm volatile("s_waitcnt vmcnt(0)" ::: "memory");
            const unsigned og = xb_add(&bar[XB_TOP], 1u);
            const unsigned tg = og / nx;
            if (og + 1u == (tg + 1u) * nx) xb_add(&bar[XB_TOPGEN], 1u);
            else XB_SPIN(xb_ld(&bar[XB_TOPGEN]) == tg, bar);
            __builtin_amdgcn_fence(__ATOMIC_ACQUIRE, "agent");
            xb_add(&bar[XB_XGEN(x)], 1u);
            asm volatile("s_waitcnt vmcnt(0)" ::: "memory");
        } else {
            XB_SPIN(xb_ld(&bar[XB_XGEN(x)]) == gen, bar);
            __builtin_amdgcn_fence(__ATOMIC_ACQUIRE, "agent");
            asm volatile("s_waitcnt vmcnt(0)" ::: "memory");
        }
    }
    __syncthreads();
}

struct EpiAll {
  int type, perm;
  unsigned char* ws; float* x; const float* f0; int rowbase, lshift; float scale; int pm0;
  __device__ __forceinline__ void operator()(const Acc& acc, const Unit& u0, int wr, int wc, int fr, int fq) const {
    asm volatile("" : "+v"(fr), "+v"(fq));
    Unit u = u0; u.pm += pm0;
    switch (type) {
      case 0: { EpiG1 E{ws, f0}; E(acc, u, wr, wc, fr, fq); break; }
      case 1: { EpiDFT E{ws, rowbase, lshift, scale}; E(acc, u, wr, wc, fr, fq); break; }
      case 2: { EpiG2 E{ws}; E(acc, u, wr, wc, fr, fq); break; }
      default: { EpiG3 E{x, f0}; E(acc, u, wr, wc, fr, fq); break; }
    }
  }
  __device__ __forceinline__ void hook(Acc& acc, const Unit& u0, int wr, int wc, int fr, int fq) const {
    asm volatile("" : "+v"(fr), "+v"(fq));
    Unit u = u0; u.pm += pm0;
    EpiG2 E{ws}; E.hook(acc, u, wr, wc, fr, fq);
  }
};

__global__ void __launch_bounds__(512, 2) fwd_megakernel(P p_arg) {
#if defined(__HIP_DEVICE_COMPILE__)
  extern __shared__ __attribute__((aligned(16))) unsigned char shm[];
  cg::grid_group grid = cg::this_grid();
  LAS unsigned char* lds = (LAS unsigned char*)shm;
  const int bid = blockIdx.x, G = gridDim.x;
  volatile LAS unsigned* xb_st = (volatile LAS unsigned*)(lds + 131072);
  if (threadIdx.x == 0) { xb_st[0] = 0u; xb_st[1] = 0u; }
  __syncthreads();
  for (int si = 0; si < 64; ++si) {
    const __attribute__((address_space(4))) P* pp = (const __attribute__((address_space(4))) P*)__builtin_amdgcn_kernarg_segment_ptr(); asm volatile("" : "+s"(pp));
    const unsigned code = pp->prog[si];
    if (code == 0xFFu) break;
    P p;
    p.x_prompt = pp->x_prompt; p.x_sample = pp->x_sample; p.state = pp->state; p.c = pp->c; p.c_ctx = pp->c_ctx; p.norm_w = pp->norm_w; p.w_ada = pp->w_ada; p.b_ada = pp->b_ada; p.w_in = pp->w_in;
    p.lb_raw = pp->lb_raw; p.gnorm_w = pp->gnorm_w; p.w_pa = pp->w_pa; p.w_pb = pp->w_pb; p.w_o = pp->w_o; p.final_w = pp->final_w; p.out = pp->out; p.ws = pp->ws;
    unsigned char* ws = p.ws;
    int tid = threadIdx.x; asm volatile("" : "+v"(tid));
    const int k = code & 15, l = (code >> 4) & 3;
    if (k == 8) { if (bid == 0) for (int i = tid; i < XCD_BAR_WORDS; i += 512) ((unsigned*)ws)[i] = 0u;
      p0_prologue(p, shm, tid); }
    else if (k == 9) { phase_final(p, tid); }
    else if (k == 0) phase_h(p, l, l == 0, tid);
    else if (k == 3) {
      int parity = 0;
      if (bid < 128) { for (int ci = 256 + bid * 2; ci < 256 + bid * 2 + 2; ++ci) scan_chain(p, l, ci >> 4, (ci >> 1) & 7, ci & 1, 0, 0, shm, parity, tid); }
      else {
        const int b2 = bid - 128;
        for (int ci = b2 * 2; ci < b2 * 2 + 2; ++ci) scan_chain(p, l, ci >> 4, (ci >> 1) & 7, ci & 1, 0, 0, shm, parity, tid);
        const int a0 = b2 < 64 ? b2 : 64 + (b2 - 64) * 2, an = b2 < 64 ? 1 : 2;
        for (int ai = a0; ai < a0 + an; ++ai) { const int ch = ai / 3, sg = ai - ch * 3; scan_chain(p, l, 32 + (ch >> 4), (ch >> 1) & 7, ch & 1, 1, sg, shm, parity, tid); }
      }
    }
    else if (k == 11) {
      int parity = 0; const int ch = bid >> 2, sg = bid & 3;
      scan_chain(p, l, 32 + (ch >> 4), (ch >> 1) & 7, ch & 1, 2, sg, shm, parity, tid);
    }
    else if (k == 4) phase_fin(p, l, tid);
    else if (k == 10) { }
    else if (k == 12) phase_fold(p, tid);
    else {
      Gemm g; StaticOrder S; EpiAll E; E.ws = ws; E.x = p.out; E.f0 = nullptr; E.rowbase = 0; E.lshift = 0; E.scale = 0.f; E.pm0 = 0;
      if (k == 1) { g = Gemm{(const u16*)(ws + WS_H), (const u16*)(ws + WS_WIN) + (size_t)l * NG1 * 1024, NTOK, NG1, 1024}; S.init(NTOK, NG1, G, bid);
        E.type = 0; E.perm = 1; E.f0 = (const float*)(ws + WS_LBS) + l * 2048; }
      else if (k == 2) {
        E.type = 1; E.perm = 1;
        if (bid < 128) { g = Gemm{(const u16*)(ws + WS_DFTS), (const u16*)(ws + WS_H), 4096, 2048, 4096}; S.init(4096, 2048, 128, bid);
          E.rowbase = NPROMPT; E.lshift = 12; E.scale = 0.001381067932f; }
        else { g = Gemm{(const u16*)(ws + WS_DFTP), (const u16*)(ws + WS_UT), 256, 16384, 512}; S.init(256, 16384, 64, bid < 192 ? bid - 128 : -1);
          E.rowbase = 0; E.lshift = 8; E.scale = 0.005524271728f; }
      }
      else {
        const bool isG2 = (k == 5) || (k == 6 && bid < 128);
        const int p0 = (k == 5) ? 0 : (k == 6 ? (bid < 128 ? 64 : 0) : 32), np = (k == 6) ? 32 : 64;
        const int gsz = (k == 6) ? 128 : G, gc = (k == 6 && bid >= 128) ? bid - 128 : bid;
        E.pm0 = p0; E.perm = 0;
        if (isG2) { g = Gemm{(const u16*)(ws + WS_YAB) + (size_t)p0 * 256 * 1536, (const u16*)(ws + WS_WPA) + (size_t)l * 1024 * 1536, np * 256, 1024, 1536}; E.type = 2; }
        else { g = Gemm{(const u16*)(ws + WS_MERGED) + (size_t)p0 * 256 * 1024, (const u16*)(ws + WS_WO) + (size_t)l * 1024 * 1024, np * 256, 1024, 1024}; E.type = 4; E.f0 = (const float*)(ws + WS_MOD) + (size_t)l * 5 * 3072; }
        S.init(np * 256, 1024, gsz, gc);
      }
      pg8::gemm_phase(lds, g, S, E, tid);
      __syncthreads();
    }
    if (code & 0x80u) {
      if (k == 8) { grid.sync(); if (tid == 0) (void)xb_add(&((unsigned*)ws)[XB_XCNT(xb_xcc_id())], 1u); }
      else xcd_barrier((unsigned*)ws, xb_st, tid);
    }
  }
#endif
}

extern "C" void kernel_launch(void* const* d_in, const int* in_sizes, int n_in, void* d_out, int out_size,
                              void* d_ws, size_t ws_size, hipStream_t stream) {
  static int grid_blocks = 0;
  if (!grid_blocks) {
    int dev = 0, cus = 0, per_cu = 0;
    if (n_in != 15 || ws_size < WS_END) { fprintf(stderr, "kernel_launch: unexpected inputs / workspace (%d, %zu)\n", n_in, ws_size); grid_blocks = -1; return; }
    (void)hipGetDevice(&dev);
    (void)hipDeviceGetAttribute(&cus, hipDeviceAttributeMultiprocessorCount, dev);
    (void)hipFuncSetAttribute((const void*)fwd_megakernel, hipFuncAttributeMaxDynamicSharedMemorySize, LDS_BYTES);
    (void)hipOccupancyMaxActiveBlocksPerMultiprocessor(&per_cu, (const void*)fwd_megakernel, 512, LDS_BYTES);
    if (per_cu < 1 || cus < 256) { fprintf(stderr, "kernel_launch: occupancy %d x %d CUs cannot hold the 256-workgroup grid\n", per_cu, cus); grid_blocks = -1; return; }
    grid_blocks = 256;
  }
  if (grid_blocks < 0) return;
  P p{};
  p.x_prompt = (const float*)d_in[0]; p.x_sample = (const float*)d_in[1]; p.state = (const float*)d_in[2]; p.c = (const float*)d_in[3]; p.c_ctx = (const float*)d_in[4];
  p.norm_w = (const float*)d_in[5]; p.w_ada = (const float*)d_in[6]; p.b_ada = (const float*)d_in[7]; p.w_in = (const float*)d_in[8]; p.lb_raw = (const float*)d_in[9];
  p.gnorm_w = (const float*)d_in[10]; p.w_pa = (const float*)d_in[11]; p.w_pb = (const float*)d_in[12]; p.w_o = (const float*)d_in[13]; p.final_w = (const float*)d_in[14];
  p.out = (float*)d_out; p.ws = (unsigned char*)d_ws;
  {
#ifndef REPMASK
#define REPMASK 0
#endif
    static const unsigned char nosync[13] = {0, 0, 1, 0, 0, 0, 0, 0, 0, 1, 0, 0, 0};
    int n = 0;
    auto emit = [&](int k, int l) { const int reps = ((REPMASK >> k) & 1) ? 2 : 1;
      for (int r = 0; r < reps; ++r) p.prog[n++] = (unsigned char)(k | (l << 4) | ((nosync[k] && r + 1 == reps) ? 0 : 0x80)); };
    emit(8, 0);
    for (int l = 0; l < DEPTH; ++l) for (int k = 0; k < 8; ++k) { if (k == 2) emit(12, l); emit(k, l); if (k == 3) emit(11, l); }
#ifdef NOPSYNCS
    for (int i = 0; i < NOPSYNCS; ++i) p.prog[n++] = (unsigned char)(10 | 0x80);
#endif
    emit(9, 0);
    while (n < 64) p.prog[n++] = 0xFF;
  }
  void* args[] = {&p};
  hipError_t e = hipLaunchCooperativeKernel((void*)fwd_megakernel, dim3(grid_blocks), dim3(512), args, LDS_BYTES, stream);
  if (e != hipSuccess) fprintf(stderr, "cooperative launch failed: %s\n", hipGetErrorString(e));
}
```

```cpp
#include <hip/hip_runtime.h>
#include <hip/hip_cooperative_groups.h>
#include <cstdio>
#include <cstdint>
namespace cg = cooperative_groups;

#define LAS __attribute__((address_space(3)))
typedef unsigned short u16;
typedef short bf16x8 __attribute__((ext_vector_type(8)));
typedef float f32x4 __attribute__((ext_vector_type(4)));
typedef unsigned u32x4 __attribute__((ext_vector_type(4)));
typedef unsigned u32x2 __attribute__((ext_vector_type(2)));

constexpr int DM = 1024, NTOK = 24576, NPROMPT = 8192, DEPTH = 4, NG1 = 8704, DIN = 8192;
constexpr int LDS_BYTES = 144 * 1024;
constexpr size_t MiB = 1u << 20;
constexpr size_t WS_MOD = 1 * MiB;
constexpr size_t WS_LBS = WS_MOD + 256 * 1024;
constexpr size_t WS_DFTP = 2 * MiB;
constexpr size_t WS_WIN = 4 * MiB;
constexpr size_t WS_WPA = 72 * MiB;
constexpr size_t WS_WPB = 80 * MiB;
constexpr size_t WS_WO = 84 * MiB;
constexpr size_t WS_DFTS = 92 * MiB;
constexpr size_t WS_H = 156 * MiB;
constexpr size_t WS_Q = 204 * MiB;
constexpr size_t WS_LF = 252 * MiB;
constexpr size_t WS_LB = 300 * MiB;
constexpr size_t WS_V = 348 * MiB;
constexpr size_t WS_ZA = 396 * MiB;
constexpr size_t WS_ZB = 444 * MiB;
constexpr size_t WS_GA = 468 * MiB;
constexpr size_t WS_GB = 516 * MiB;
constexpr size_t WS_UT = 564 * MiB;
constexpr size_t WS_YAB = 612 * MiB;
constexpr size_t WS_OF = 684 * MiB;
constexpr size_t WS_OB = 780 * MiB;
constexpr size_t WS_SLOC = 876 * MiB;
constexpr size_t WS_LSEG = 1 * MiB + 512 * 1024;
constexpr size_t WS_END = 889 * MiB;
constexpr size_t WS_MERGED = WS_OB;
constexpr size_t UT_SAMPLE_OFF = (size_t)32 * 512 * 512;

struct P {
  const float *x_prompt, *x_sample, *state, *c, *c_ctx, *norm_w, *w_ada, *b_ada, *w_in, *lb_raw, *gnorm_w, *w_pa, *w_pb, *w_o, *final_w;
  float* out; unsigned char* ws;
  unsigned char prog[64];
};

typedef float f32x2v __attribute__((ext_vector_type(2)));
typedef __bf16 bf16x2v __attribute__((ext_vector_type(2)));
__device__ __forceinline__ unsigned pk2(float lo, float hi) { const f32x2v v = {lo, hi}; const bf16x2v b = __builtin_convertvector(v, bf16x2v); return __builtin_bit_cast(unsigned, b); }
__device__ __forceinline__ u16 f2bf(float f) { unsigned u = __float_as_uint(f); u += 0x7FFFu + ((u >> 16) & 1u); return (u16)(u >> 16); }
__device__ __forceinline__ float bf2f(unsigned b) { return __uint_as_float(b << 16); }
__device__ __forceinline__ float bflo(unsigned w) { return __uint_as_float(w << 16); }
__device__ __forceinline__ float bfhi(unsigned w) { return __uint_as_float(w & 0xFFFF0000u); }
__device__ __forceinline__ float h2f(unsigned short h) { return (float)__builtin_bit_cast(_Float16, h); }
__device__ __forceinline__ unsigned short f2h(float f) { return __builtin_bit_cast(unsigned short, (_Float16)f); }
__device__ __forceinline__ float siluf(float x) { return x * __builtin_amdgcn_rcpf(1.f + __expf(-x)); }
__device__ __forceinline__ float sigmf(float x) { return __builtin_amdgcn_rcpf(1.f + __expf(-x)); }
__device__ __forceinline__ float wave_sum(float v) {
#pragma unroll
  for (int o = 1; o < 64; o <<= 1) v += __shfl_xor(v, o);
  return v;
}

namespace pg8 {
constexpr int BM = 256, BK = 64, HALF = 128, HTB = HALF * BK * 2, STAGE_BYTES = 8 * HTB, NXCD = 8, WGM = 4;
__host__ __device__ __forceinline__ int lds_byte(int r, int c) { const int st = (r >> 4) * 2 + (c >> 5), rr = r & 15, cc = c & 31, ob = rr * 64 + cc * 2; return st * 1024 + (ob ^ (((ob >> 9) & 1) << 5)); }
__host__ __device__ __forceinline__ void stage_rc(int b, int& R, int& C) { const int st = b / 1024, sb = b % 1024, swz = sb ^ (((sb >> 9) & 1) << 5); R = (st >> 1) * 16 + swz / 64; C = (st & 1) * 32 + (swz % 64) / 2; }
__host__ __device__ __forceinline__ int perm32(int rho) { const int n = rho >> 4, i = rho & 15; return 8 * (i >> 2) + 4 * n + (i & 3); }
struct Unit { int pm, pn; };
struct Gemm { const u16* A; const u16* Bt; int M, N, K; };
struct StaticOrder {
  int nM, nN, nwg, G, c;
  __device__ void init(int M, int N, int G_, int c_) { nM = M / BM; nN = N / BM; nwg = nM * nN; G = G_; c = c_; }
  __device__ bool next(int i, Unit& u) const {
    const long L = (long)i * G + c; if (c < 0 || L >= nwg) return false;
    int wgid = (int)L; { const int q = nwg / NXCD, r = nwg % NXCD, xcd = wgid % NXCD, off = wgid / NXCD; wgid = (xcd < r ? xcd * (q + 1) : r * (q + 1) + (xcd - r) * q) + off; }
    const int nig = WGM * nN, gid = wgid / nig, fm = gid * WGM, gsz = (nM - fm) < WGM ? (nM - fm) : WGM;
    u.pm = fm + ((wgid % nig) % gsz); u.pn = (wgid % nig) / gsz; return true;
  }
};
template <class Epi>
__device__ __forceinline__ void gemm_phase(LAS unsigned char* lds, const Gemm g, const StaticOrder& S, const Epi& E, const int tid) {
  const int wid = __builtin_amdgcn_readfirstlane(tid >> 6), lane = tid & 63, wr = wid >> 2, wc = wid & 3, fr = lane & 15, fq = lane >> 4;
  const int K = g.K, nt = K / BK;
  unsigned voffA[2], voffB[2];
#pragma unroll
  for (int i = 0; i < 2; ++i) { int R, C; stage_rc(tid * 16 + i * 8192, R, C); const int Rb = E.perm ? ((R & ~31) + perm32(R & 31)) : R;
    voffA[i] = (unsigned)(R * K + C) * 2u; voffB[i] = (unsigned)(Rb * K + C) * 2u; }
  const size_t kstep = (size_t)(BK * 2);
  const size_t hstep = (size_t)HALF * K * 2;
  const size_t tstep = 2 * hstep;
  const unsigned ldsw = (unsigned)wid * 1024u;
  const int aoff = lds_byte(wr * 64 + fr, fq * 8), boff = lds_byte(wc * 32 + fr, fq * 8);
#define PG8_SA(b, h) (((b) * 2 + (h)) * HTB)
#define PG8_SB(b, h) ((4 + (b) * 2 + (h)) * HTB)
#define PG8_STAGE(bufoff, gbase, voff) do { _Pragma("unroll") for (int _i = 0; _i < 2; ++_i) \
    __builtin_amdgcn_global_load_lds((const unsigned*)((const char*)(gbase) + (voff)[_i]), (LAS unsigned*)(lds + (bufoff) + ldsw + _i * 8192), 16, 0, 0); } while (0)
#define PG8_LDA(dst, b, h) do { _Pragma("unroll") for (int m = 0; m < 4; ++m) _Pragma("unroll") for (int k = 0; k < 2; ++k) dst[m][k] = *(const LAS bf16x8*)(lds + PG8_SA(b, h) + aoff + m * 2048 + k * 1024); } while (0)
#define PG8_LDB(dst, b, h) do { _Pragma("unroll") for (int n = 0; n < 2; ++n) _Pragma("unroll") for (int k = 0; k < 2; ++k) dst[n][k] = *(const LAS bf16x8*)(lds + PG8_SB(b, h) + boff + n * 2048 + k * 1024); } while (0)
#define PG8_MMA(ai, bj, At, Bt) do { __builtin_amdgcn_s_setprio(1); _Pragma("unroll") for (int m = 0; m < 4; ++m) _Pragma("unroll") for (int n = 0; n < 2; ++n) _Pragma("unroll") for (int k = 0; k < 2; ++k) \
    acc[ai][bj][m][n] = __builtin_amdgcn_mfma_f32_16x16x32_bf16(Bt[n][k], At[m][k], acc[ai][bj][m][n], 0, 0, 0); __builtin_amdgcn_s_setprio(0); } while (0)
#define PG8_WAIT_V(n) asm volatile("s_waitcnt vmcnt(" #n ")" ::: "memory")
#define PG8_WAIT_L(n) asm volatile("s_waitcnt lgkmcnt(" #n ")" ::: "memory")
#define PG8_BAR __builtin_amdgcn_s_barrier()
#define PG8_SCHED __builtin_amdgcn_sched_barrier(0)
  Unit cur, nxt; int ui = 0;
  if (!S.next(0, cur)) return;
  f32x4 acc[2][2][4][2];
#pragma unroll
  for (int a = 0; a < 2; ++a)
#pragma unroll
    for (int b = 0; b < 2; ++b)
#pragma unroll
      for (int m = 0; m < 4; ++m)
#pragma unroll
        for (int n = 0; n < 2; ++n) acc[a][b][m][n] = (f32x4){0.f, 0.f, 0.f, 0.f};
  bf16x8 At[4][2], B0[2][2], B1[2][2];
  const char* cA = (const char*)g.A + (size_t)cur.pm * tstep; const char* cB = (const char*)g.Bt + (size_t)cur.pn * tstep;
  PG8_STAGE(PG8_SB(0, 0), cB, voffB); PG8_STAGE(PG8_SA(0, 0), cA, voffA); PG8_STAGE(PG8_SB(0, 1), cB + hstep, voffB); PG8_STAGE(PG8_SA(0, 1), cA + hstep, voffA);
  if (wr == 1) PG8_BAR;
  PG8_WAIT_V(4); PG8_BAR;
  PG8_STAGE(PG8_SB(1, 0), cB + kstep, voffB); PG8_STAGE(PG8_SA(1, 0), cA + kstep, voffA); PG8_STAGE(PG8_SB(1, 1), cB + hstep + kstep, voffB);
  PG8_WAIT_V(6); PG8_BAR;
  for (;;) {
    const bool has_next = S.next(ui + 1, nxt);
    const char* nA = has_next ? (const char*)g.A + (size_t)nxt.pm * tstep : cA; const char* nB = has_next ? (const char*)g.Bt + (size_t)nxt.pn * tstep : cB;
    for (int t = 0; t < nt; t += 2) {
      const bool last = (t == nt - 2);
      if (E.type == 2 && t == 16) E.hook(acc, cur, wr, wc, fr, fq);
      const char* a1 = cA + (size_t)(t + 1) * kstep;
      const char* a2 = last ? nA : cA + (size_t)(t + 2) * kstep; const char* b2 = last ? nB : cB + (size_t)(t + 2) * kstep;
      const char* a3 = a2 + kstep; const char* b3 = b2 + kstep;
      PG8_LDB(B0, 0, 0); PG8_SCHED; PG8_LDA(At, 0, 0); PG8_STAGE(PG8_SA(1, 1), a1 + hstep, voffA);
      PG8_WAIT_L(8); PG8_BAR; PG8_WAIT_L(0); PG8_MMA(0, 0, At, B0); PG8_BAR; PG8_SCHED;
      PG8_LDB(B1, 0, 1); PG8_STAGE(PG8_SB(0, 0), b2, voffB);
      PG8_BAR; PG8_WAIT_L(0); PG8_MMA(0, 1, At, B1); PG8_BAR;
      PG8_LDA(At, 0, 1); PG8_STAGE(PG8_SA(0, 0), a2, voffA);
      PG8_BAR; PG8_WAIT_L(0); PG8_MMA(1, 0, At, B0); PG8_BAR; PG8_SCHED;
      PG8_STAGE(PG8_SB(0, 1), b2 + hstep, voffB);
      PG8_WAIT_V(6); PG8_BAR; PG8_MMA(1, 1, At, B1); PG8_BAR;
      PG8_LDB(B0, 1, 0); PG8_SCHED; PG8_LDA(At, 1, 0); PG8_STAGE(PG8_SA(0, 1), a2 + hstep, voffA);
      PG8_WAIT_L(8); PG8_BAR; PG8_WAIT_L(0); PG8_MMA(0, 0, At, B0); PG8_BAR; PG8_SCHED;
      PG8_LDB(B1, 1, 1); PG8_STAGE(PG8_SB(1, 0), b3, voffB);
      PG8_BAR; PG8_WAIT_L(0); PG8_MMA(0, 1, At, B1); PG8_BAR;
      PG8_LDA(At, 1, 1); PG8_STAGE(PG8_SA(1, 0), a3, voffA);
      PG8_BAR; PG8_WAIT_L(0); PG8_MMA(1, 0, At, B0); PG8_BAR; PG8_SCHED;
      PG8_STAGE(PG8_SB(1, 1), b3 + hstep, voffB);
      PG8_WAIT_V(6); PG8_BAR; PG8_MMA(1, 1, At, B1); PG8_BAR;
    }
    E(acc, cur, wr, wc, fr, fq);
    if (!has_next) break;
#pragma unroll
    for (int a = 0; a < 2; ++a)
#pragma unroll
      for (int b = 0; b < 2; ++b)
#pragma unroll
        for (int m = 0; m < 4; ++m)
#pragma unroll
          for (int n = 0; n < 2; ++n) acc[a][b][m][n] = (f32x4){0.f, 0.f, 0.f, 0.f};
    cur = nxt; cA = nA; cB = nB; ++ui;
  }
  PG8_WAIT_V(0);
  if (wr == 0) PG8_BAR;
  PG8_BAR;
#undef PG8_SA
#undef PG8_SB
#undef PG8_STAGE
#undef PG8_LDA
#undef PG8_LDB
#undef PG8_MMA
#undef PG8_WAIT_V
#undef PG8_WAIT_L
#undef PG8_BAR
#undef PG8_SCHED
}
}
using pg8::Unit; using pg8::Gemm; using pg8::StaticOrder;
typedef f32x4 Acc[2][2][4][2];

struct EpiG1 {
  static constexpr bool PERM = true;
  unsigned char* ws; const float* lbs;
  __device__ __forceinline__ void operator()(const Acc& acc, const Unit& u, int wr, int wc, int fr, int fq) const {
    const int pn = u.pn, row0 = u.pm * 256 + wr * 64 + fr;
    if (pn >= 20 && pn < 24) {
      u16* UT = (u16*)(ws + WS_UT);
      const int part = (pn - 20) >> 1;
#pragma unroll
      for (int ai = 0; ai < 2; ++ai)
#pragma unroll
        for (int m = 0; m < 4; ++m) {
          const int r = row0 + ai * 128 + m * 16;
          size_t base; size_t chs;
          if (r < NPROMPT) { const int bp = r >> 8, l = r & 255; base = (size_t)bp * 512 * 512 + part * 256 + l; chs = 512; }
          else { const int rr = r - NPROMPT, b = rr >> 12, l = rr & 4095; base = UT_SAMPLE_OFF + (size_t)b * 512 * 8192 + part * 4096 + l; chs = 8192; }
#pragma unroll
          for (int bj = 0; bj < 2; ++bj) {
            const int ch0 = ((pn - 20) & 1) * 256 + bj * 128 + wc * 32 + 8 * fq;
#pragma unroll
            for (int n = 0; n < 2; ++n)
#pragma unroll
              for (int e = 0; e < 4; e += 2) { const unsigned pr = pk2(acc[ai][bj][m][n][e], acc[ai][bj][m][n][e + 1]);
                UT[base + (size_t)(ch0 + 4 * n + e) * chs] = (u16)(pr & 0xFFFFu); UT[base + (size_t)(ch0 + 4 * n + e + 1) * chs] = (u16)(pr >> 16); }
          }
        }
      return;
    }
    int act, ld = 1024, colt; size_t off;
    if (pn < 4) { act = 1; off = WS_Q; colt = pn * 256; }
    else if (pn < 8) { act = 3; off = WS_LF; colt = (pn - 4) * 256; }
    else if (pn < 12) { act = 4; off = WS_LB; colt = (pn - 8) * 256; }
    else if (pn < 16) { act = 0; off = WS_V; colt = (pn - 12) * 256; }
    else if (pn < 20) { act = 1; off = WS_ZA; colt = (pn - 16) * 256; }
    else if (pn < 26) { act = 1; off = WS_ZB; colt = (pn - 24) * 256; ld = 512; }
    else if (pn < 30) { act = 2; off = WS_GA; colt = (pn - 26) * 256; }
    else { act = 2; off = WS_GB; colt = (pn - 30) * 256; }
    u16* dst = (u16*)(ws + off);
    const int col0 = colt + wc * 32 + 8 * fq;
    f32x4 lbv[2][2];
    if (act >= 3) { const float* lb = lbs + (act == 4 ? 1024 : 0) + col0;
#pragma unroll
      for (int bj = 0; bj < 2; ++bj) { lbv[bj][0] = *(const f32x4*)(lb + bj * 128); lbv[bj][1] = *(const f32x4*)(lb + bj * 128 + 4); } }
#pragma unroll
    for (int ai = 0; ai < 2; ++ai)
#pragma unroll
      for (int m = 0; m < 4; ++m) {
        u16* rowp = dst + (size_t)(row0 + ai * 128 + m * 16) * ld + col0;
#pragma unroll
        for (int bj = 0; bj < 2; ++bj) {
          float v[8];
#pragma unroll
          for (int e = 0; e < 8; ++e) v[e] = acc[ai][bj][m][e >> 2][e & 3];
          u32x4 o;
          if (act >= 3) {
            unsigned short hv[8];
#pragma unroll
            for (int e = 0; e < 8; ++e) { const float oml = 1.f - lbv[bj][e >> 2][e & 3]; const float kk = oml * __builtin_amdgcn_rcpf(1.f + __expf(v[e])); hv[e] = f2h(fmaxf(__log2f(1.f - kk), -57.f)); }
            o[0] = hv[0] | ((unsigned)hv[1] << 16); o[1] = hv[2] | ((unsigned)hv[3] << 16); o[2] = hv[4] | ((unsigned)hv[5] << 16); o[3] = hv[6] | ((unsigned)hv[7] << 16);
          } else {
            if (act == 1) {
#pragma unroll
              for (int e = 0; e < 8; ++e) v[e] = siluf(v[e]);
            } else if (act == 2) {
#pragma unroll
              for (int e = 0; e < 8; ++e) v[e] = sigmf(v[e]);
            }
            o[0] = pk2(v[0], v[1]); o[1] = pk2(v[2], v[3]); o[2] = pk2(v[4], v[5]); o[3] = pk2(v[6], v[7]);
          }
          *(u32x4*)(rowp + bj * 128) = o;
        }
      }
  }
};
struct EpiDFT {
  static constexpr bool PERM = true;
  unsigned char* ws; int rowbase, lshift; float scale;
  __device__ __forceinline__ void operator()(const Acc& acc, const Unit& u, int wr, int wc, int fr, int fq) const {
    const u16* ZB = (const u16*)(ws + WS_ZB); u16* YB = (u16*)(ws + WS_YAB);
    const int k0 = u.pm * 256 + wr * 64 + fr;
    const int n0 = u.pn * 256 + wc * 32 + 8 * fq, b = n0 >> 9, ch0 = n0 & 511;
    const size_t R0 = (size_t)rowbase + ((size_t)b << lshift) + k0;
    const u16* zb = ZB + R0 * 512 + ch0; u16* yb = YB + R0 * 1536 + 1024 + ch0;
#pragma unroll
    for (int ai = 0; ai < 2; ++ai) {
      u32x4 z[4][2];
#pragma unroll
      for (int m = 0; m < 4; ++m)
#pragma unroll
        for (int bj = 0; bj < 2; ++bj) z[m][bj] = *(const u32x4*)(zb + (ai * 128 + m * 16) * 512 + bj * 128);
#pragma unroll
      for (int m = 0; m < 4; ++m)
#pragma unroll
        for (int bj = 0; bj < 2; ++bj) {
          const u32x4 zz = z[m][bj]; u32x4 o;
          o[0] = pk2(acc[ai][bj][m][0][0] * scale * bflo(zz[0]), acc[ai][bj][m][0][1] * scale * bfhi(zz[0]));
          o[1] = pk2(acc[ai][bj][m][0][2] * scale * bflo(zz[1]), acc[ai][bj][m][0][3] * scale * bfhi(zz[1]));
          o[2] = pk2(acc[ai][bj][m][1][0] * scale * bflo(zz[2]), acc[ai][bj][m][1][1] * scale * bfhi(zz[2]));
          o[3] = pk2(acc[ai][bj][m][1][2] * scale * bflo(zz[3]), acc[ai][bj][m][1][3] * scale * bfhi(zz[3]));
          *(u32x4*)(yb + (ai * 128 + m * 16) * 1536 + bj * 128) = o;
        }
      __builtin_amdgcn_sched_barrier(0);
    }
  }
};
struct EpiG2 {
  static constexpr bool PERM = false;
  unsigned char* ws;
  __device__ __forceinline__ void hook(Acc& acc, const Unit& u, int wr, int wc, int fr, int fq) const {
    const u16* GA = (const u16*)(ws + WS_GA); const u16* GB = (const u16*)(ws + WS_GB);
    const int row0 = u.pm * 256 + wr * 64 + fr, col0 = u.pn * 256 + wc * 32 + 4 * fq;
#pragma unroll
    for (int ai = 0; ai < 2; ++ai) {
      u32x2 ga[4][2][2], gb[4][2][2];
#pragma unroll
      for (int m = 0; m < 4; ++m)
#pragma unroll
        for (int bj = 0; bj < 2; ++bj)
#pragma unroll
          for (int n = 0; n < 2; ++n) { const size_t idx = (size_t)(row0 + ai * 128 + m * 16) * 1024 + col0 + bj * 128 + n * 16;
            ga[m][bj][n] = *(const u32x2*)(GA + idx); gb[m][bj][n] = *(const u32x2*)(GB + idx); }
#pragma unroll
      for (int m = 0; m < 4; ++m)
#pragma unroll
        for (int bj = 0; bj < 2; ++bj)
#pragma unroll
          for (int n = 0; n < 2; ++n) { const u32x2 a = ga[m][bj][n], b = gb[m][bj][n]; f32x4& v = acc[ai][bj][m][n];
            v[0] *= bflo(a[0]) * __builtin_amdgcn_rcpf(fmaxf(bflo(b[0]), 1e-30f)); v[1] *= bfhi(a[0]) * __builtin_amdgcn_rcpf(fmaxf(bfhi(b[0]), 1e-30f));
            v[2] *= bflo(a[1]) * __builtin_amdgcn_rcpf(fmaxf(bflo(b[1]), 1e-30f)); v[3] *= bfhi(a[1]) * __builtin_amdgcn_rcpf(fmaxf(bfhi(b[1]), 1e-30f)); }
      __builtin_amdgcn_sched_barrier(0);
    }
  }
  __device__ __forceinline__ void operator()(const Acc& acc, const Unit& u, int wr, int wc, int fr, int fq) const {
    const u16* GB = (const u16*)(ws + WS_GB); u16* MG = (u16*)(ws + WS_MERGED);
    const int row0 = u.pm * 256 + wr * 64 + fr, col0 = u.pn * 256 + wc * 32 + 4 * fq;
#pragma unroll
    for (int ai = 0; ai < 2; ++ai) {
      u32x2 gb[4][2][2];
#pragma unroll
      for (int m = 0; m < 4; ++m)
#pragma unroll
        for (int bj = 0; bj < 2; ++bj)
#pragma unroll
          for (int n = 0; n < 2; ++n) gb[m][bj][n] = *(const u32x2*)(GB + (size_t)(row0 + ai * 128 + m * 16) * 1024 + col0 + bj * 128 + n * 16);
#pragma unroll
      for (int m = 0; m < 4; ++m)
#pragma unroll
        for (int bj = 0; bj < 2; ++bj)
#pragma unroll
          for (int n = 0; n < 2; ++n) { const u32x2 b = gb[m][bj][n]; const f32x4 v = acc[ai][bj][m][n];
            u32x2 o; o[0] = pk2(v[0] * bflo(b[0]), v[1] * bfhi(b[0])); o[1] = pk2(v[2] * bflo(b[1]), v[3] * bfhi(b[1]));
            *(u32x2*)(MG + (size_t)(row0 + ai * 128 + m * 16) * 1024 + col0 + bj * 128 + n * 16) = o; }
      __builtin_amdgcn_sched_barrier(0);
    }
  }
};
struct EpiG3 {
  static constexpr bool PERM = false;
  float* x; const float* modl;
  __device__ __forceinline__ void operator()(const Acc& acc, const Unit& u, int wr, int wc, int fr, int fq) const {
    const int j = u.pm < 32 ? 0 : 1 + ((u.pm - 32) >> 4);
    const float* gt = modl + j * 3072 + 2048;
    const int row0 = u.pm * 256 + wr * 64 + fr, col0 = u.pn * 256 + wc * 32 + 4 * fq;
    f32x4 gv[2][2];
#pragma unroll
    for (int bj = 0; bj < 2; ++bj)
#pragma unroll
      for (int n = 0; n < 2; ++n) gv[bj][n] = *(const f32x4*)(gt + col0 + bj * 128 + n * 16);
#pragma unroll
    for (int ai = 0; ai < 2; ++ai)
#pragma unroll
      for (int mp = 0; mp < 2; ++mp) {
        f32x4 xv[2][2][2];
#pragma unroll
        for (int mi = 0; mi < 2; ++mi)
#pragma unroll
          for (int bj = 0; bj < 2; ++bj)
#pragma unroll
            for (int n = 0; n < 2; ++n) xv[mi][bj][n] = *(const f32x4*)(x + (size_t)(row0 + ai * 128 + (2 * mp + mi) * 16) * 1024 + col0 + bj * 128 + n * 16);
#pragma unroll
        for (int mi = 0; mi < 2; ++mi)
#pragma unroll
          for (int bj = 0; bj < 2; ++bj)
#pragma unroll
            for (int n = 0; n < 2; ++n) *(f32x4*)(x + (size_t)(row0 + ai * 128 + (2 * mp + mi) * 16) * 1024 + col0 + bj * 128 + n * 16) = xv[mi][bj][n] + gv[bj][n] * acc[ai][bj][2 * mp + mi][n];
        __builtin_amdgcn_sched_barrier(0);
      }
  }
};

__device__ __forceinline__ void p0_prologue(const P& p, unsigned char* shm, const int tid) {
  const int bid = blockIdx.x, G = gridDim.x;
  float* fs = (float*)shm;
  for (int i = bid * 512 + tid; i < 2048; i += G * 512) {
    float r[4], mx = -1e30f;
    for (int l = 0; l < 4; ++l) { r[l] = p.lb_raw[l * 2048 + i]; mx = fmaxf(mx, r[l]); }
    float s = 0.f; for (int l = 0; l < 4; ++l) { r[l] = expf(r[l] - mx); s += r[l]; }
    float cs = 0.f; float* lbs = (float*)(p.ws + WS_LBS);
    for (int l = 0; l < 4; ++l) { if (l > 0) cs += r[l] / s; lbs[l * 2048 + i] = cs; }
  }
  for (int it = bid; it < 96; it += G) {
    const int l = it / 24, n0 = (it % 24) * 128;
    for (int i = tid; i < 5120; i += 512) { const int j = i >> 10, k = i & 1023; const float cv = j == 0 ? p.c_ctx[k] : p.c[(j - 1) * 1024 + k]; fs[i] = cv / (1.f + expf(-cv)); }
    __syncthreads();
    const int col = tid & 127, kq = tid >> 7;
    float a[5] = {0.f, 0.f, 0.f, 0.f, 0.f};
    const float* w = p.w_ada + ((size_t)l * 1024 + kq * 256) * 3072 + n0 + col;
    for (int k = 0; k < 256; k += 32) {
      float wv[32];
#pragma unroll
      for (int u = 0; u < 32; ++u) wv[u] = w[(size_t)(k + u) * 3072];
#pragma unroll
      for (int u = 0; u < 32; ++u)
#pragma unroll
        for (int j = 0; j < 5; ++j) a[j] += fs[j * 1024 + kq * 256 + k + u] * wv[u];
    }
    __syncthreads();
#pragma unroll
    for (int j = 0; j < 5; ++j) fs[5120 + (kq * 5 + j) * 128 + col] = a[j];
    __syncthreads();
    if (tid < 128) {
      float* modv = (float*)(p.ws + WS_MOD);
#pragma unroll
      for (int j = 0; j < 5; ++j) { const float s = fs[5120 + (0 * 5 + j) * 128 + tid] + fs[5120 + (1 * 5 + j) * 128 + tid] + fs[5120 + (2 * 5 + j) * 128 + tid] + fs[5120 + (3 * 5 + j) * 128 + tid];
        modv[((size_t)l * 5 + j) * 3072 + n0 + tid] = s + p.b_ada[l * 3072 + n0 + tid]; }
    }
    __syncthreads();
  }
  for (int it = bid; it < 256; it += G) {
    const int l = it >> 6, g = (it >> 4) & 3, k0 = (it & 15) * 64;
    for (int i = tid; i < 64 * 32; i += 512) { const int kk = i >> 5, c4 = (i & 31) * 4;
      const f32x4 v = *(const f32x4*)(p.w_in + ((size_t)l * 1024 + k0 + kk) * DIN + 5120 + g * 128 + c4);
      fs[(c4 + 0) * 68 + kk] = v[0]; fs[(c4 + 1) * 68 + kk] = v[1]; fs[(c4 + 2) * 68 + kk] = v[2]; fs[(c4 + 3) * 68 + kk] = v[3]; }
    __syncthreads();
    const int m = tid & 127, kq = tid >> 7;
    float sm, cm; sincospif((float)m / 64.f, &sm, &cm);
    float cr = 1.f, sr = 0.f, ac[16], as[16];
#pragma unroll
    for (int i = 0; i < 16; ++i) { ac[i] = 0.f; as[i] = 0.f; }
    for (int c = 0; c < 128; ++c) {
      const float* wrow = fs + c * 68 + kq * 16;
#pragma unroll
      for (int i4 = 0; i4 < 4; ++i4) { const f32x4 wv = *(const f32x4*)(wrow + i4 * 4);
#pragma unroll
        for (int e = 0; e < 4; ++e) { ac[i4 * 4 + e] += wv[e] * cr; as[i4 * 4 + e] -= wv[e] * sr; } }
      const float c2 = cr * cm - sr * sm, s2 = sr * cm + cr * sm; cr = c2; sr = s2;
    }
    u16* WIN = (u16*)(p.ws + WS_WIN) + (size_t)l * NG1 * 1024;
    u32x4 o0, o1, o2, o3;
    o0[0] = pk2(ac[0], ac[1]); o0[1] = pk2(ac[2], ac[3]); o0[2] = pk2(ac[4], ac[5]); o0[3] = pk2(ac[6], ac[7]);
    o1[0] = pk2(ac[8], ac[9]); o1[1] = pk2(ac[10], ac[11]); o1[2] = pk2(ac[12], ac[13]); o1[3] = pk2(ac[14], ac[15]);
    o2[0] = pk2(as[0], as[1]); o2[1] = pk2(as[2], as[3]); o2[2] = pk2(as[4], as[5]); o2[3] = pk2(as[6], as[7]);
    o3[0] = pk2(as[8], as[9]); o3[1] = pk2(as[10], as[11]); o3[2] = pk2(as[12], as[13]); o3[3] = pk2(as[14], as[15]);
    u16* dc = WIN + (size_t)(5120 + g * 128 + m) * 1024 + k0 + kq * 16;
    u16* ds = WIN + (size_t)(5120 + 512 + g * 128 + m) * 1024 + k0 + kq * 16;
    *(u32x4*)dc = o0; *(u32x4*)(dc + 8) = o1; *(u32x4*)ds = o2; *(u32x4*)(ds + 8) = o3;
    __syncthreads();
  }
  {
    constexpr int I_IN = 16 * 120, I_PA = 16 * 16, I_PB = 8 * 16, I_O = 16 * 16, I_L = I_IN + I_PA + I_PB + I_O;
    for (int it0 = bid; it0 < 4 * I_L; it0 += 4 * G) {
#pragma unroll
      for (int q = 0; q < 4; ++q) {
        const int it = it0 + q * G; if (it >= 4 * I_L) break;
        const int l = it / I_L; int r = it % I_L;
        const float* W; int Nsrc, kb, nsrc0;
        if (r < I_IN) { kb = r / 120; const int nb = r % 120; nsrc0 = nb * 64 + (nb * 64 >= 5120 ? 512 : 0); W = p.w_in + (size_t)l * 1024 * DIN; Nsrc = DIN; }
        else if ((r -= I_IN) < I_PA) { kb = r / 16; nsrc0 = (r % 16) * 64; W = p.w_pa + (size_t)l * 1024 * 1024; Nsrc = 1024; }
        else if ((r -= I_PA) < I_PB) { kb = r / 16; nsrc0 = (r % 16) * 64; W = p.w_pb + (size_t)l * 512 * 1024; Nsrc = 1024; }
        else { r -= I_PB; kb = r / 16; nsrc0 = (r % 16) * 64; W = p.w_o + (size_t)l * 1024 * 1024; Nsrc = 1024; }
        const int k0 = kb * 64;
#pragma unroll
        for (int ps = 0; ps < 8; ++ps) { const int kk = ps * 8 + (tid >> 6), nn = tid & 63; fs[q * 4160 + kk * 65 + nn] = W[(size_t)(k0 + kk) * Nsrc + nsrc0 + nn]; }
      }
      __syncthreads();
#pragma unroll
      for (int q = 0; q < 4; ++q) {
        const int it = it0 + q * G; if (it >= 4 * I_L) break;
        const int l = it / I_L; int r = it % I_L;
        u16* WT; int Kd, kb, ndst0;
        if (r < I_IN) { kb = r / 120; const int nb = r % 120; ndst0 = nb * 64; if (ndst0 >= 5120) ndst0 += 1024; WT = (u16*)(p.ws + WS_WIN) + (size_t)l * NG1 * 1024; Kd = 1024; }
        else if ((r -= I_IN) < I_PA) { kb = r / 16; ndst0 = (r % 16) * 64; WT = (u16*)(p.ws + WS_WPA) + (size_t)l * 1024 * 1536; Kd = 1536; }
        else if ((r -= I_PA) < I_PB) { kb = r / 16; ndst0 = (r % 16) * 64; WT = (u16*)(p.ws + WS_WPA) + (size_t)l * 1024 * 1536 + 1024; Kd = 1536; }
        else { r -= I_PB; kb = r / 16; ndst0 = (r % 16) * 64; WT = (u16*)(p.ws + WS_WO) + (size_t)l * 1024 * 1024; Kd = 1024; }
        const int k0 = kb * 64;
        const int nn = tid >> 3, kc = tid & 7; const float* sp = fs + q * 4160 + (8 * kc) * 65 + nn;
        u32x4 o; o[0] = pk2(sp[0], sp[65]); o[1] = pk2(sp[2 * 65], sp[3 * 65]); o[2] = pk2(sp[4 * 65], sp[5 * 65]); o[3] = pk2(sp[6 * 65], sp[7 * 65]);
        *(u32x4*)(WT + (size_t)(ndst0 + nn) * Kd + k0 + 8 * kc) = o;
      }
      __syncthreads();
    }
  }
  {
    __syncthreads();
    for (int r = tid; r < 4096; r += 512) { float sv, cv; sincospif((float)r * (1.f / 2048.f), &sv, &cv); fs[r] = cv; fs[4096 + r] = sv; }
    __syncthreads();
    u16* DS = (u16*)(p.ws + WS_DFTS);
    for (size_t i = (size_t)bid * 512 + tid; i < (size_t)4096 * 512; i += (size_t)G * 512) {
      const int k = (int)(i >> 9), j0 = (int)(i & 511) * 8; const int part = j0 >> 11, jj = j0 & 2047;
      const float* tb = fs + part * 4096;
      float v[8];
#pragma unroll
      for (int e = 0; e < 8; ++e) v[e] = tb[(k * (jj + e)) & 4095];
      if (part == 1 && jj == 0) v[0] = (k & 1) ? -1.f : 1.f;
      u32x4 o; o[0] = pk2(v[0], v[1]); o[1] = pk2(v[2], v[3]); o[2] = pk2(v[4], v[5]); o[3] = pk2(v[6], v[7]);
      *(u32x4*)(DS + (size_t)k * 4096 + j0) = o;
    }
    u16* DP = (u16*)(p.ws + WS_DFTP);
    for (int i = bid * 512 + tid; i < 256 * 64; i += G * 512) {
      const int k = i >> 6, j0 = (i & 63) * 8; const int part = j0 >> 8, jj = j0 & 255;
      const float* tb = fs + part * 4096;
      float v[8];
#pragma unroll
      for (int e = 0; e < 8; ++e) v[e] = tb[((k * (jj + e)) & 255) * 16];
      u32x4 o; o[0] = pk2(v[0], v[1]); o[1] = pk2(v[2], v[3]); o[2] = pk2(v[4], v[5]); o[3] = pk2(v[6], v[7]);
      *(u32x4*)(DP + (size_t)k * 512 + j0) = o;
    }
  }
}

__device__ __forceinline__ void phase_fold(const P& p, const int tid) {
  const u16* UT = (const u16*)(p.ws + WS_UT) + UT_SAMPLE_OFF; u16* UF = (u16*)(p.ws + WS_H);
  for (int it = blockIdx.x * 512 + tid; it < 2048 * 512; it += gridDim.x * 512) {
    const int n = it >> 9, c = it & 511, part = c >> 8, cc = c & 255;
    const u16* base = UT + (size_t)n * 8192 + part * 4096;
    const u32x4 f = *(const u32x4*)(base + 8 * cc), g = *(const u32x4*)(base + 4096 - 8 * cc - 8);
    float fw[8], bw[8];
#pragma unroll
    for (int e = 0; e < 4; ++e) { fw[2 * e] = bflo(f[e]); fw[2 * e + 1] = bfhi(f[e]); }
    float gv[8];
#pragma unroll
    for (int e = 0; e < 4; ++e) { gv[2 * e] = bflo(g[e]); gv[2 * e + 1] = bfhi(g[e]); }
#pragma unroll
    for (int e = 1; e < 8; ++e) bw[e] = gv[8 - e];
    bw[0] = cc ? bf2f(base[4096 - 8 * cc]) : 0.f;
    float o[8];
#pragma unroll
    for (int e = 0; e < 8; ++e) o[e] = part ? fw[e] - bw[e] : fw[e] + bw[e];
    if (cc == 0) o[0] = part ? bf2f(UT[(size_t)n * 8192 + 2048]) : fw[0];
    u32x4 ov; ov[0] = pk2(o[0], o[1]); ov[1] = pk2(o[2], o[3]); ov[2] = pk2(o[4], o[5]); ov[3] = pk2(o[6], o[7]);
    *(u32x4*)(UF + (size_t)n * 4096 + part * 2048 + 8 * cc) = ov;
  }
}

__device__ __forceinline__ void phase_h(const P& p, int l, bool first, const int tid) {
  const int lane = tid & 63, gw = blockIdx.x * 8 + (tid >> 6), ngw = gridDim.x * 8;
  const float* modl = (const float*)(p.ws + WS_MOD) + (size_t)l * 5 * 3072;
  u16* H = (u16*)(p.ws + WS_H);
  float pef[4] = {0.f, 0.f, 0.f, 0.f};
  if (first) {
#pragma unroll
    for (int e = 0; e < 4; ++e) pef[e] = 1.0f / powf(10000.0f, (float)(4 * lane + e) / 256.0f);
  }
  for (int r = gw; r < NTOK; r += ngw) {
    const int j = r < NPROMPT ? 0 : 1 + ((r - NPROMPT) >> 12);
    float* xr = p.out + (size_t)r * 1024;
    f32x4 v[4];
    if (first) {
      const float* src = r < NPROMPT ? p.x_prompt + (size_t)r * 1024 : p.x_sample + (size_t)(r - NPROMPT) * 1024;
#pragma unroll
      for (int i = 0; i < 4; ++i) v[i] = *(const f32x4*)(src + 4 * (lane + 64 * i));
      if (r >= NPROMPT) {
        const int pos = (r - NPROMPT) & 4095; const float pr = (float)(pos >> 6), pc = (float)(pos & 63);
#pragma unroll
        for (int e = 0; e < 4; ++e) {
          const float fr_ = pef[e];
          v[0][e] += sinf(pr * fr_); v[1][e] += cosf(pr * fr_); v[2][e] += sinf(pc * fr_); v[3][e] += cosf(pc * fr_);
        }
      }
#pragma unroll
      for (int i = 0; i < 4; ++i) *(f32x4*)(xr + 4 * (lane + 64 * i)) = v[i];
    } else {
#pragma unroll
      for (int i = 0; i < 4; ++i) v[i] = *(const f32x4*)(xr + 4 * (lane + 64 * i));
    }
    float ss = 0.f;
#pragma unroll
    for (int i = 0; i < 4; ++i) ss += (v[i][0] * v[i][0] + v[i][1] * v[i][1]) + (v[i][2] * v[i][2] + v[i][3] * v[i][3]);
    const float rstd = rsqrtf(wave_sum(ss) * (1.f / 1024.f) + 1e-6f);
#pragma unroll
    for (int i = 0; i < 4; ++i) {
      const int e0 = 4 * (lane + 64 * i);
      const f32x4 nw = *(const f32x4*)(p.norm_w + l * 1024 + e0), sh = *(const f32x4*)(modl + j * 3072 + e0), sc = *(const f32x4*)(modl + j * 3072 + 1024 + e0);
      f32x4 hh;
#pragma unroll
      for (int e = 0; e < 4; ++e) hh[e] = (v[i][e] * rstd) * nw[e] * (1.f + sc[e]) + sh[e];
      u32x2 o; o[0] = pk2(hh[0], hh[1]); o[1] = pk2(hh[2], hh[3]);
      *(u32x2*)(H + (size_t)r * 1024 + e0) = o;
    }
  }
}

constexpr int SC_QB = 0, SC_KB = 8704, SC_KLT = 17408, SC_DEC = 26624, SC_EM = 27136, SC_P = 27648, SC_BUF = 29184;
__device__ __forceinline__ float ex2(float x) { return __builtin_amdgcn_exp2f(x); }
__device__ __forceinline__ void scan_chain(const P& p, int l, int seq, int hh, int dir, int mode, int seg, unsigned char* shm, int& parity, const int tid) {
  const int w = tid >> 6, lane = tid & 63, fr = lane & 15, fq = lane >> 4;
  const bool samp = seq >= 32;
  const int L = samp ? 4096 : 256, rowbase = samp ? NPROMPT + (seq - 32) * 4096 : seq * 256, nch = mode ? 32 : (L >> 5), n0 = mode ? seg * 32 : 0;
  const int chain = (seq - 32) * 16 + hh * 2 + dir;
  const long cstep = dir ? -32 * 1024 : 32 * 1024;
  const long rstr = dir ? -1024 : 1024;
  const size_t e0 = (size_t)((long)((size_t)rowbase + (dir ? L - 1 : 0)) * 1024 + hh * 128 + (long)n0 * cstep);
  const u16* Qc = (const u16*)(p.ws + WS_Q) + e0;
  const u16* LFc = (const u16*)(p.ws + (dir ? WS_LB : WS_LF)) + e0;
  const u16* Vc = (const u16*)(p.ws + WS_V) + e0;
  u16* Oc = (u16*)(p.ws + (dir ? WS_OB : WS_OF)) + e0;
  const int sg = dir ? -1 : 1;
  const int off_t = sg * (fq * 8) * 1024 + w * 16 + fr;
  const int off_c0 = sg * fr * 1024 + w * 16 + fq * 4;
  const int off_v = sg * (fq * 4) * 1024 + w * 16 + fr;
  f32x4 S[8];
  if (mode == 1 || !samp) {
#pragma unroll
    for (int cb = 0; cb < 8; ++cb) S[cb] = (f32x4){0.f, 0.f, 0.f, 0.f};
  } else {
    const float* s0 = p.state + ((((size_t)(seq - 32) * 4 + l) * 2 + dir) * 8 + hh) * 16384 + w * 16 + fr;
#pragma unroll
    for (int cb = 0; cb < 8; ++cb)
#pragma unroll
      for (int j = 0; j < 4; ++j) S[cb][j] = s0[(cb * 16 + fq * 4 + j) * 128];
    for (int g = 0; g < seg; ++g) {
      const float* sl = (const float*)(p.ws + WS_SLOC) + ((size_t)chain * 3 + g) * 16384 + w * 16 + fr;
      const float* lg = (const float*)(p.ws + WS_LSEG) + ((size_t)chain * 3 + g) * 128 + fq * 4;
#pragma unroll
      for (int cb = 0; cb < 8; ++cb) { const f32x4 lv4 = *(const f32x4*)(lg + cb * 16);
#pragma unroll
        for (int j = 0; j < 4; ++j) S[cb][j] = ex2(lv4[j]) * S[cb][j] + sl[(cb * 16 + fq * 4 + j) * 128]; }
    }
  }
  f32x4 lsum = {0.f, 0.f, 0.f, 0.f};
  bf16x8 Lm[2];
#pragma unroll
  for (int tb = 0; tb < 2; ++tb)
#pragma unroll
    for (int j = 0; j < 8; ++j) Lm[tb][j] = (fq * 8 + j <= tb * 16 + fr) ? (short)0x3F80 : (short)0;
  u16 n_lft[8], n_v[8]; u32x2 n_lfc[2], n_qc[2] = {{0u, 0u}, {0u, 0u}};
#define SC_LOAD(QP, LP, VP) do { \
    _Pragma("unroll") for (int j = 0; j < 8; ++j) n_lft[j] = ((LP) + j * rstr)[off_t]; \
    _Pragma("unroll") for (int tb = 0; tb < 2; ++tb) { n_lfc[tb] = *(const u32x2*)((LP) + tb * 16 * rstr + off_c0); if (mode != 1) n_qc[tb] = *(const u32x2*)((QP) + tb * 16 * rstr + off_c0); } \
    _Pragma("unroll") for (int i = 0; i < 8; ++i) n_v[i] = ((VP) + ((i >> 2) * 16 + (i & 3)) * rstr)[off_v]; } while (0)
  SC_LOAD(Qc, LFc, Vc);
  for (int n = 0; n < nch; ++n) {
    u16 lft[8], vv[8]; u32x2 lfc[2], qc[2];
#pragma unroll
    for (int j = 0; j < 8; ++j) { lft[j] = n_lft[j]; vv[j] = n_v[j]; }
    lfc[0] = n_lfc[0]; lfc[1] = n_lfc[1]; qc[0] = n_qc[0]; qc[1] = n_qc[1];
    u16* Ocur = Oc;
    Qc += cstep; LFc += cstep; Vc += cstep; Oc += cstep;
    if (n + 1 < nch) SC_LOAD(Qc, LFc, Vc);
    unsigned char* buf = shm + (parity & 1) * SC_BUF; parity ^= 1;
    bf16x8 ahi, alo, vop;
    {
      unsigned hb[8], lb2[8];
#pragma unroll
      for (int j = 0; j < 8; ++j) { const float x = h2f(lft[j]); const unsigned xb = __float_as_uint(x) & 0xFFFF0000u; hb[j] = xb; lb2[j] = __float_as_uint(x - __uint_as_float(xb)); }
      u32x4 ph, pl, pv;
#pragma unroll
      for (int j = 0; j < 4; ++j) { ph[j] = (hb[2 * j] >> 16) | hb[2 * j + 1]; pl[j] = (lb2[2 * j] >> 16) | (lb2[2 * j + 1] & 0xFFFF0000u); pv[j] = (unsigned)vv[2 * j] | ((unsigned)vv[2 * j + 1] << 16); }
      ahi = __builtin_bit_cast(bf16x8, ph); alo = __builtin_bit_cast(bf16x8, pl); vop = __builtin_bit_cast(bf16x8, pv);
    }
    f32x4 b[2];
#pragma unroll
    for (int tb = 0; tb < 2; ++tb) {
      b[tb] = __builtin_amdgcn_mfma_f32_16x16x32_bf16(ahi, Lm[tb], (f32x4){0.f, 0.f, 0.f, 0.f}, 0, 0, 0);
      b[tb] = __builtin_amdgcn_mfma_f32_16x16x32_bf16(alo, Lm[tb], b[tb], 0, 0, 0);
    }
    f32x4 blast, bmid, elm;
#pragma unroll
    for (int j = 0; j < 4; ++j) { blast[j] = __shfl(b[1][j], (lane & 48) | 15); bmid[j] = __shfl(b[0][j], (lane & 48) | 15); elm[j] = ex2(blast[j] - bmid[j]); }
    lsum += blast;
#pragma unroll
    for (int tb = 0; tb < 2; ++tb) {
      float qv[4], lv[4], qb[4], kb[4], kl[4];
      qv[0] = bflo(qc[tb][0]); qv[1] = bfhi(qc[tb][0]); qv[2] = bflo(qc[tb][1]); qv[3] = bfhi(qc[tb][1]);
      lv[0] = h2f((u16)(lfc[tb][0] & 0xFFFF)); lv[1] = h2f((u16)(lfc[tb][0] >> 16)); lv[2] = h2f((u16)(lfc[tb][1] & 0xFFFF)); lv[3] = h2f((u16)(lfc[tb][1] >> 16));
#pragma unroll
      for (int j = 0; j < 4; ++j) { const float kk = 1.f - ex2(lv[j]), d = b[tb][j] - bmid[j]; qb[j] = qv[j] * ex2(d); kb[j] = kk * ex2(-d); kl[j] = kb[j] * elm[j]; }
      if (mode != 1) {
        u32x2 o; o[0] = pk2(qb[0], qb[1]); o[1] = pk2(qb[2], qb[3]);
        *(u32x2*)(buf + SC_QB + (tb * 16 + fr) * 272 + (w * 16 + fq * 4) * 2) = o;
        o[0] = pk2(kb[0], kb[1]); o[1] = pk2(kb[2], kb[3]);
        *(u32x2*)(buf + SC_KB + (tb * 16 + fr) * 272 + (w * 16 + fq * 4) * 2) = o;
      }
      const unsigned k01 = pk2(kl[0], kl[1]), k23 = pk2(kl[2], kl[3]);
      unsigned char* kp = buf + SC_KLT + (w * 16 + fq * 4) * 72 + (tb * 16 + fr) * 2;
      *(u16*)(kp) = (u16)(k01 & 0xFFFFu); *(u16*)(kp + 72) = (u16)(k01 >> 16); *(u16*)(kp + 144) = (u16)(k23 & 0xFFFFu); *(u16*)(kp + 216) = (u16)(k23 >> 16);
    }
    if (fr == 0) { f32x4 d, em;
#pragma unroll
      for (int j = 0; j < 4; ++j) { em[j] = ex2(bmid[j]); d[j] = em[j] * elm[j]; }
      *(f32x4*)(buf + SC_DEC + (w * 16 + fq * 4) * 4) = d; *(f32x4*)(buf + SC_EM + (w * 16 + fq * 4) * 4) = em; }
    __syncthreads();
    f32x4 o0 = {0.f, 0.f, 0.f, 0.f}, o1 = o0;
    if (mode != 1) {
      if (w < 3) {
        const int krow = (w == 2 ? 16 : 0) + fr, qrow = (w == 0 ? 0 : 16) + fr;
        f32x4 at = {0.f, 0.f, 0.f, 0.f};
#pragma unroll
        for (int kbk = 0; kbk < 4; ++kbk) {
          const bf16x8 kf = *(const bf16x8*)(buf + SC_KB + krow * 272 + kbk * 64 + fq * 16), qf = *(const bf16x8*)(buf + SC_QB + qrow * 272 + kbk * 64 + fq * 16);
          at = __builtin_amdgcn_mfma_f32_16x16x32_bf16(kf, qf, at, 0, 0, 0);
        }
        if (w != 1) {
#pragma unroll
          for (int j = 0; j < 4; ++j) at[j] = (fq * 4 + j <= fr) ? at[j] : 0.f;
        }
        u32x2 pw; pw[0] = pk2(at[0], at[1]); pw[1] = pk2(at[2], at[3]);
        *(u32x2*)(buf + SC_P + w * 512 + lane * 8) = pw;
      }
#pragma unroll
      for (int kbk = 0; kbk < 4; ++kbk) {
        const f32x4 e0v = *(const f32x4*)(buf + SC_EM + (2 * kbk * 16 + fq * 4) * 4), e1v = *(const f32x4*)(buf + SC_EM + ((2 * kbk + 1) * 16 + fq * 4) * 4);
        const f32x4 s0 = S[2 * kbk] * e0v, s1 = S[2 * kbk + 1] * e1v;
        u32x4 sp; sp[0] = pk2(s0[0], s0[1]); sp[1] = pk2(s0[2], s0[3]); sp[2] = pk2(s1[0], s1[1]); sp[3] = pk2(s1[2], s1[3]);
        const bf16x8 sop = __builtin_bit_cast(bf16x8, sp);
        u32x4 qa, qb2;
        { const u32x2 x0 = *(const u32x2*)(buf + SC_QB + fr * 272 + kbk * 64 + fq * 8), x1 = *(const u32x2*)(buf + SC_QB + fr * 272 + kbk * 64 + 32 + fq * 8); qa[0] = x0[0]; qa[1] = x0[1]; qa[2] = x1[0]; qa[3] = x1[1]; }
        { const u32x2 x0 = *(const u32x2*)(buf + SC_QB + (16 + fr) * 272 + kbk * 64 + fq * 8), x1 = *(const u32x2*)(buf + SC_QB + (16 + fr) * 272 + kbk * 64 + 32 + fq * 8); qb2[0] = x0[0]; qb2[1] = x0[1]; qb2[2] = x1[0]; qb2[3] = x1[1]; }
        o0 = __builtin_amdgcn_mfma_f32_16x16x32_bf16(__builtin_bit_cast(bf16x8, qa), sop, o0, 0, 0, 0);
        o1 = __builtin_amdgcn_mfma_f32_16x16x32_bf16(__builtin_bit_cast(bf16x8, qb2), sop, o1, 0, 0, 0);
      }
    }
#pragma unroll
    for (int cb = 0; cb < 8; ++cb) {
      const f32x4 d = *(const f32x4*)(buf + SC_DEC + (cb * 16 + fq * 4) * 4);
      u32x4 ka; { const u32x2 x0 = *(const u32x2*)(buf + SC_KLT + (cb * 16 + fr) * 72 + fq * 8), x1 = *(const u32x2*)(buf + SC_KLT + (cb * 16 + fr) * 72 + 32 + fq * 8); ka[0] = x0[0]; ka[1] = x0[1]; ka[2] = x1[0]; ka[3] = x1[1]; }
      S[cb] = __builtin_amdgcn_mfma_f32_16x16x32_bf16(__builtin_bit_cast(bf16x8, ka), vop, d * S[cb], 0, 0, 0);
    }
    if (mode != 1) {
      __syncthreads();
      const u32x2 t0 = *(const u32x2*)(buf + SC_P + lane * 8), t1 = *(const u32x2*)(buf + SC_P + 512 + lane * 8), t2 = *(const u32x2*)(buf + SC_P + 1024 + lane * 8);
      u32x4 pp; pp[0] = t0[0]; pp[1] = t0[1]; pp[2] = 0u; pp[3] = 0u;
      o0 = __builtin_amdgcn_mfma_f32_16x16x32_bf16(__builtin_bit_cast(bf16x8, pp), vop, o0, 0, 0, 0);
      pp[0] = t1[0]; pp[1] = t1[1]; pp[2] = t2[0]; pp[3] = t2[1];
      o1 = __builtin_amdgcn_mfma_f32_16x16x32_bf16(__builtin_bit_cast(bf16x8, pp), vop, o1, 0, 0, 0);
#pragma unroll
      for (int j = 0; j < 4; j += 2) { const unsigned a = pk2(o0[j], o0[j + 1]), b = pk2(o1[j], o1[j + 1]);
        (Ocur + j * rstr)[off_v] = (u16)(a & 0xFFFFu); (Ocur + (j + 1) * rstr)[off_v] = (u16)(a >> 16); (Ocur + (16 + j) * rstr)[off_v] = (u16)(b & 0xFFFFu); (Ocur + (17 + j) * rstr)[off_v] = (u16)(b >> 16); }
    }
  }
#undef SC_LOAD
  if (mode == 1) {
    float* sl = (float*)(p.ws + WS_SLOC) + ((size_t)chain * 3 + seg) * 16384 + w * 16 + fr;
#pragma unroll
    for (int cb = 0; cb < 8; ++cb)
#pragma unroll
      for (int j = 0; j < 4; ++j) sl[(cb * 16 + fq * 4 + j) * 128] = S[cb][j];
    if (fr == 0) *(f32x4*)((float*)(p.ws + WS_LSEG) + ((size_t)chain * 3 + seg) * 128 + w * 16 + fq * 4) = lsum;
  }
  if (!samp) {
    float* ns = p.out + (size_t)NTOK * 1024 + ((((size_t)seq * 4 + l) * 2 + dir) * 8 + hh) * 16384 + w * 16 + fr;
#pragma unroll
    for (int cb = 0; cb < 8; ++cb)
#pragma unroll
      for (int j = 0; j < 4; ++j) ns[(cb * 16 + fq * 4 + j) * 128] = S[cb][j];
  }
}

__device__ __forceinline__ void phase_fin(const P& p, int l, const int tid) {
  const int lane = tid & 63, gw = blockIdx.x * 8 + (tid >> 6), ngw = gridDim.x * 8;
  const u16* OF = (const u16*)(p.ws + WS_OF); const u16* OB = (const u16*)(p.ws + WS_OB);
  const u16* ZA = (const u16*)(p.ws + WS_ZA); u16* YA = (u16*)(p.ws + WS_YAB);
  const float* gw_ = p.gnorm_w + l * 1024 + lane * 16;
  for (int r = gw; r < NTOK; r += ngw) {
    const size_t base = (size_t)r * 1024 + lane * 16;
    const u32x4 f0 = *(const u32x4*)(OF + base), f1 = *(const u32x4*)(OF + base + 8), b0 = *(const u32x4*)(OB + base), b1 = *(const u32x4*)(OB + base + 8);
    f32x4 o[4]; float ss = 0.f;
#pragma unroll
    for (int i = 0; i < 2; ++i) {
      o[i][0] = bflo(f0[2 * i]) + bflo(b0[2 * i]); o[i][1] = bfhi(f0[2 * i]) + bfhi(b0[2 * i]); o[i][2] = bflo(f0[2 * i + 1]) + bflo(b0[2 * i + 1]); o[i][3] = bfhi(f0[2 * i + 1]) + bfhi(b0[2 * i + 1]);
      o[2 + i][0] = bflo(f1[2 * i]) + bflo(b1[2 * i]); o[2 + i][1] = bfhi(f1[2 * i]) + bfhi(b1[2 * i]); o[2 + i][2] = bflo(f1[2 * i + 1]) + bflo(b1[2 * i + 1]); o[2 + i][3] = bfhi(f1[2 * i + 1]) + bfhi(b1[2 * i + 1]); }
#pragma unroll
    for (int i = 0; i < 4; ++i) ss += (o[i][0] * o[i][0] + o[i][1] * o[i][1]) + (o[i][2] * o[i][2] + o[i][3] * o[i][3]);
    ss += __shfl_xor(ss, 1); ss += __shfl_xor(ss, 2); ss += __shfl_xor(ss, 4);
    const float rstd = rsqrtf(ss * (1.f / 128.f) + 1e-6f);
    const u32x4 z0 = *(const u32x4*)(ZA + base), z1 = *(const u32x4*)(ZA + base + 8);
    float zf[16];
#pragma unroll
    for (int i = 0; i < 4; ++i) { zf[2 * i] = bflo(z0[i]); zf[2 * i + 1] = bfhi(z0[i]); zf[8 + 2 * i] = bflo(z1[i]); zf[8 + 2 * i + 1] = bfhi(z1[i]); }
    float y[16];
#pragma unroll
    for (int i = 0; i < 4; ++i) { const f32x4 g = *(const f32x4*)(gw_ + 4 * i);
#pragma unroll
      for (int e = 0; e < 4; ++e) y[4 * i + e] = o[i][e] * rstd * g[e] * zf[4 * i + e]; }
    u32x4 a, b2;
    a[0] = pk2(y[0], y[1]); a[1] = pk2(y[2], y[3]); a[2] = pk2(y[4], y[5]); a[3] = pk2(y[6], y[7]);
    b2[0] = pk2(y[8], y[9]); b2[1] = pk2(y[10], y[11]); b2[2] = pk2(y[12], y[13]); b2[3] = pk2(y[14], y[15]);
    *(u32x4*)(YA + (size_t)r * 1536 + lane * 16) = a; *(u32x4*)(YA + (size_t)r * 1536 + lane * 16 + 8) = b2;
  }
}

__device__ __forceinline__ void phase_final(const P& p, const int tid) {
  const int lane = tid & 63, gw = blockIdx.x * 8 + (tid >> 6), ngw = gridDim.x * 8;
  for (int r = gw; r < NTOK; r += ngw) {
    float* xr = p.out + (size_t)r * 1024;
    f32x4 v[4]; float ss = 0.f;
#pragma unroll
    for (int i = 0; i < 4; ++i) { v[i] = *(const f32x4*)(xr + 4 * (lane + 64 * i)); ss += (v[i][0] * v[i][0] + v[i][1] * v[i][1]) + (v[i][2] * v[i][2] + v[i][3] * v[i][3]); }
    const float rstd = rsqrtf(wave_sum(ss) * (1.f / 1024.f) + 1e-6f);
#pragma unroll
    for (int i = 0; i < 4; ++i) { const f32x4 fw = *(const f32x4*)(p.final_w + 4 * (lane + 64 * i)); *(f32x4*)(xr + 4 * (lane + 64 * i)) = v[i] * rstd * fw; }
  }
}

#define XB_TMO      128
#define XB_XCNT(j)  (256  + 64 * (j))
#define XB_XSUB(j)  (1280 + 64 * (j))
#define XB_XGEN(j)  (2304 + 64 * (j))
#define XB_TOP      3328
#define XB_TOPGEN   3392
#define XCD_BAR_WORDS 3456
#define XB_SPIN_CAP (1u << 18)
__device__ __forceinline__ unsigned xb_ld(unsigned* p)              { return __hip_atomic_load(p, __ATOMIC_RELAXED, __HIP_MEMORY_SCOPE_AGENT); }
__device__ __forceinline__ unsigned xb_add(unsigned* p, unsigned v) { return __hip_atomic_fetch_add(p, v, __ATOMIC_RELAXED, __HIP_MEMORY_SCOPE_AGENT); }
__device__ __forceinline__ unsigned xb_xcc_id() { return (unsigned)__builtin_amdgcn_s_getreg((3 << 11) | 20) & 0xFu; }
#define XB_SPIN(cond, bar) do { unsigned _sp = 0; while (cond) { __builtin_amdgcn_s_sleep(1); \
    if ((++_sp & 255u) == 0u) { if (xb_ld(&(bar)[XB_TMO])) break; if (_sp > XB_SPIN_CAP) { atomicAdd(&(bar)[XB_TMO], 1u); break; } } } } while (0)
__device__ __forceinline__ void xcd_barrier_complete(unsigned* bar, unsigned x, unsigned& nloc, unsigned& nx) {
    const unsigned G = gridDim.x * gridDim.y * gridDim.z;
    unsigned sum, cnt, mine, sp = 0u;
    for (;;) {
        sum = 0u; cnt = 0u; mine = 0u;
#pragma unroll
        for (unsigned j = 0; j < 16; ++j) { const unsigned c = xb_ld(&bar[XB_XCNT(j)]); sum += c; cnt += (c > 0u) ? 1u : 0u; mine = (j == x) ? c : mine; }
        if (sum == G) break;
        __builtin_amdgcn_s_sleep(1);
        if ((++sp & 255u) == 0u) { if (xb_ld(&bar[XB_TMO])) break; if (sp > XB_SPIN_CAP) { atomicAdd(&bar[XB_TMO], 1u); break; } }
    }
    nloc = mine > 0u ? mine : 1u; nx = cnt > 0u ? cnt : 1u;
}
__device__ __forceinline__ void xcd_barrier(unsigned* bar, volatile LAS unsigned* st, const int tid) {
    asm volatile("s_waitcnt vmcnt(0)" ::: "memory");
    __syncthreads();
    if (tid == 0) {
        const unsigned x = xb_xcc_id();
        __builtin_amdgcn_s_waitcnt(0);
        unsigned nloc = st[0], nx = st[1];
        if (nloc == 0u) { xcd_barrier_complete(bar, x, nloc, nx); st[0] = nloc; st[1] = nx; }
        const unsigned old = xb_add(&bar[XB_XSUB(x)], 1u);
        const unsigned gen = old / nloc;
        if (old + 1u == (gen + 1u) * nloc) {
            __builtin_amdgcn_fence(__ATOMIC_RELEASE, "agent");
            asm volatile("s_waitcnt vmcnt(0)" ::: "memory");
            const unsigned og = xb_add(&bar[XB_TOP], 1u);
            const unsigned tg = og / nx;
            if (og + 1u == (tg + 1u) * nx) xb_add(&bar[XB_TOPGEN], 1u);
            else XB_SPIN(xb_ld(&bar[XB_TOPGEN]) == tg, bar);
            __builtin_amdgcn_fence(__ATOMIC_ACQUIRE, "agent");
            xb_add(&bar[XB_XGEN(x)], 1u);
            asm volatile("s_waitcnt vmcnt(0)" ::: "memory");
        } else {
            XB_SPIN(xb_ld(&bar[XB_XGEN(x)]) == gen, bar);
            __builtin_amdgcn_fence(__ATOMIC_ACQUIRE, "agent");
            asm volatile("s_waitcnt vmcnt(0)" ::: "memory");
        }
    }
    __syncthreads();
}

struct EpiAll {
  int type, perm;
  unsigned char* ws; float* x; const float* f0; int rowbase, lshift; float scale; int pm0;
  __device__ __forceinline__ void operator()(const Acc& acc, const Unit& u0, int wr, int wc, int fr, int fq) const {
    asm volatile("" : "+v"(fr), "+v"(fq));
    Unit u = u0; u.pm += pm0;
    switch (type) {
      case 0: { EpiG1 E{ws, f0}; E(acc, u, wr, wc, fr, fq); break; }
      case 1: { EpiDFT E{ws, rowbase, lshift, scale}; E(acc, u, wr, wc, fr, fq); break; }
      case 2: { EpiG2 E{ws}; E(acc, u, wr, wc, fr, fq); break; }
      default: { EpiG3 E{x, f0}; E(acc, u, wr, wc, fr, fq); break; }
    }
  }
  __device__ __forceinline__ void hook(Acc& acc, const Unit& u0, int wr, int wc, int fr, int fq) const {
    asm volatile("" : "+v"(fr), "+v"(fq));
    Unit u = u0; u.pm += pm0;
    EpiG2 E{ws}; E.hook(acc, u, wr, wc, fr, fq);
  }
};

__global__ void __launch_bounds__(512, 2) fwd_megakernel(P p_arg) {
#if defined(__HIP_DEVICE_COMPILE__)
  extern __shared__ __attribute__((aligned(16))) unsigned char shm[];
  cg::grid_group grid = cg::this_grid();
  LAS unsigned char* lds = (LAS unsigned char*)shm;
  const int bid = blockIdx.x, G = gridDim.x;
  volatile LAS unsigned* xb_st = (volatile LAS unsigned*)(lds + 131072);
  if (threadIdx.x == 0) { xb_st[0] = 0u; xb_st[1] = 0u; }
  __syncthreads();
  for (int si = 0; si < 64; ++si) {
    const __attribute__((address_space(4))) P* pp = (const __attribute__((address_space(4))) P*)__builtin_amdgcn_kernarg_segment_ptr(); asm volatile("" : "+s"(pp));
    const unsigned code = pp->prog[si];
    if (code == 0xFFu) break;
    P p;
    p.x_prompt = pp->x_prompt; p.x_sample = pp->x_sample; p.state = pp->state; p.c = pp->c; p.c_ctx = pp->c_ctx; p.norm_w = pp->norm_w; p.w_ada = pp->w_ada; p.b_ada = pp->b_ada; p.w_in = pp->w_in;
    p.lb_raw = pp->lb_raw; p.gnorm_w = pp->gnorm_w; p.w_pa = pp->w_pa; p.w_pb = pp->w_pb; p.w_o = pp->w_o; p.final_w = pp->final_w; p.out = pp->out; p.ws = pp->ws;
    unsigned char* ws = p.ws;
    int tid = threadIdx.x; asm volatile("" : "+v"(tid));
    const int k = code & 15, l = (code >> 4) & 3;
    if (k == 8) { if (bid == 0) for (int i = tid; i < XCD_BAR_WORDS; i += 512) ((unsigned*)ws)[i] = 0u;
      p0_prologue(p, shm, tid); }
    else if (k == 9) { phase_final(p, tid); }
    else if (k == 0) phase_h(p, l, l == 0, tid);
    else if (k == 3) {
      int parity = 0;
      if (bid < 128) { for (int ci = 256 + bid * 2; ci < 256 + bid * 2 + 2; ++ci) scan_chain(p, l, ci >> 4, (ci >> 1) & 7, ci & 1, 0, 0, shm, parity, tid); }
      else {
        const int b2 = bid - 128;
        for (int ci = b2 * 2; ci < b2 * 2 + 2; ++ci) scan_chain(p, l, ci >> 4, (ci >> 1) & 7, ci & 1, 0, 0, shm, parity, tid);
        const int a0 = b2 < 64 ? b2 : 64 + (b2 - 64) * 2, an = b2 < 64 ? 1 : 2;
        for (int ai = a0; ai < a0 + an; ++ai) { const int ch = ai / 3, sg = ai - ch * 3; scan_chain(p, l, 32 + (ch >> 4), (ch >> 1) & 7, ch & 1, 1, sg, shm, parity, tid); }
      }
    }
    else if (k == 11) {
      int parity = 0; const int ch = bid >> 2, sg = bid & 3;
      scan_chain(p, l, 32 + (ch >> 4), (ch >> 1) & 7, ch & 1, 2, sg, shm, parity, tid);
    }
    else if (k == 4) phase_fin(p, l, tid);
    else if (k == 10) { }
    else if (k == 12) phase_fold(p, tid);
    else {
      Gemm g; StaticOrder S; EpiAll E; E.ws = ws; E.x = p.out; E.f0 = nullptr; E.rowbase = 0; E.lshift = 0; E.scale = 0.f; E.pm0 = 0;
      if (k == 1) { g = Gemm{(const u16*)(ws + WS_H), (const u16*)(ws + WS_WIN) + (size_t)l * NG1 * 1024, NTOK, NG1, 1024}; S.init(NTOK, NG1, G, bid);
        E.type = 0; E.perm = 1; E.f0 = (const float*)(ws + WS_LBS) + l * 2048; }
      else if (k == 2) {
        E.type = 1; E.perm = 1;
        if (bid < 128) { g = Gemm{(const u16*)(ws + WS_DFTS), (const u16*)(ws + WS_H), 4096, 2048, 4096}; S.init(4096, 2048, 128, bid);
          E.rowbase = NPROMPT; E.lshift = 12; E.scale = 0.001381067932f; }
        else { g = Gemm{(const u16*)(ws + WS_DFTP), (const u16*)(ws + WS_UT), 256, 16384, 512}; S.init(256, 16384, 64, bid < 192 ? bid - 128 : -1);
          E.rowbase = 0; E.lshift = 8; E.scale = 0.005524271728f; }
      }
      else {
        const bool isG2 = (k == 5) || (k == 6 && bid < 128);
        const int p0 = (k == 5) ? 0 : (k == 6 ? (bid < 128 ? 64 : 0) : 32), np = (k == 6) ? 32 : 64;
        const int gsz = (k == 6) ? 128 : G, gc = (k == 6 && bid >= 128) ? bid - 128 : bid;
        E.pm0 = p0; E.perm = 0;
        if (isG2) { g = Gemm{(const u16*)(ws + WS_YAB) + (size_t)p0 * 256 * 1536, (const u16*)(ws + WS_WPA) + (size_t)l * 1024 * 1536, np * 256, 1024, 1536}; E.type = 2; }
        else { g = Gemm{(const u16*)(ws + WS_MERGED) + (size_t)p0 * 256 * 1024, (const u16*)(ws + WS_WO) + (size_t)l * 1024 * 1024, np * 256, 1024, 1024}; E.type = 4; E.f0 = (const float*)(ws + WS_MOD) + (size_t)l * 5 * 3072; }
        S.init(np * 256, 1024, gsz, gc);
      }
      pg8::gemm_phase(lds, g, S, E, tid);
      __syncthreads();
    }
    if (code & 0x80u) {
      if (k == 8) { grid.sync(); if (tid == 0) (void)xb_add(&((unsigned*)ws)[XB_XCNT(xb_xcc_id())], 1u); }
      else xcd_barrier((unsigned*)ws, xb_st, tid);
    }
  }
#endif
}

extern "C" void kernel_launch(void* const* d_in, const int* in_sizes, int n_in, void* d_out, int out_size,
                              void* d_ws, size_t ws_size, hipStream_t stream) {
  static int grid_blocks = 0;
  if (!grid_blocks) {
    int dev = 0, cus = 0, per_cu = 0;
    if (n_in != 15 || ws_size < WS_END) { fprintf(stderr, "kernel_launch: unexpected inputs / workspace (%d, %zu)\n", n_in, ws_size); grid_blocks = -1; return; }
    (void)hipGetDevice(&dev);
    (void)hipDeviceGetAttribute(&cus, hipDeviceAttributeMultiprocessorCount, dev);
    (void)hipFuncSetAttribute((const void*)fwd_megakernel, hipFuncAttributeMaxDynamicSharedMemorySize, LDS_BYTES);
    (void)hipOccupancyMaxActiveBlocksPerMultiprocessor(&per_cu, (const void*)fwd_megakernel, 512, LDS_BYTES);
    if (per_cu < 1 || cus < 256) { fprintf(stderr, "kernel_launch: occupancy %d x %d CUs cannot hold the 256-workgroup grid\n", per_cu, cus); grid_blocks = -1; return; }
    grid_blocks = 256;
  }
  if (grid_blocks < 0) return;
  P p{};
  p.x_prompt = (const float*)d_in[0]; p.x_sample = (const float*)d_in[1]; p.state = (const float*)d_in[2]; p.c = (const float*)d_in[3]; p.c_ctx = (const float*)d_in[4];
  p.norm_w = (const float*)d_in[5]; p.w_ada = (const float*)d_in[6]; p.b_ada = (const float*)d_in[7]; p.w_in = (const float*)d_in[8]; p.lb_raw = (const float*)d_in[9];
  p.gnorm_w = (const float*)d_in[10]; p.w_pa = (const float*)d_in[11]; p.w_pb = (const float*)d_in[12]; p.w_o = (const float*)d_in[13]; p.final_w = (const float*)d_in[14];
  p.out = (float*)d_out; p.ws = (unsigned char*)d_ws;
  {
#ifndef REPMASK
#define REPMASK 0
#endif
    static const unsigned char nosync[13] = {0, 0, 1, 0, 0, 0, 0, 0, 0, 1, 0, 0, 0};
    int n = 0;
    auto emit = [&](int k, int l) { const int reps = ((REPMASK >> k) & 1) ? 2 : 1;
      for (int r = 0; r < reps; ++r) p.prog[n++] = (unsigned char)(k | (l << 4) | ((nosync[k] && r + 1 == reps) ? 0 : 0x80)); };
    emit(8, 0);
    for (int l = 0; l < DEPTH; ++l) for (int k = 0; k < 8; ++k) { if (k == 2) emit(12, l); emit(k, l); if (k == 3) emit(11, l); }
#ifdef NOPSYNCS
    for (int i = 0; i < NOPSYNCS; ++i) p.prog[n++] = (unsigned char)(10 | 0x80);
#endif
    emit(9, 0);
    while (n < 64) p.prog[n++] = 0xFF;
  }
  void* args[] = {&p};
  hipError_t e = hipLaunchCooperativeKernel((void*)fwd_megakernel, dim3(grid_blocks), dim3(512), args, LDS_BYTES, stream);
  if (e != hipSuccess) fprintf(stderr, "cooperative launch failed: %s\n", hipGetErrorString(e));
}
```

```cpp
#include <hip/hip_runtime.h>
#include <hip/hip_cooperative_groups.h>
#include <cstdio>
#include <cstdint>
namespace cg = cooperative_groups;

#define LAS __attribute__((address_space(3)))
typedef unsigned short u16;
typedef short bf16x8 __attribute__((ext_vector_type(8)));
typedef float f32x4 __attribute__((ext_vector_type(4)));
typedef unsigned u32x4 __attribute__((ext_vector_type(4)));
typedef unsigned u32x2 __attribute__((ext_vector_type(2)));

constexpr int DM = 1024, NTOK = 24576, NPROMPT = 8192, DEPTH = 4, NG1 = 8704, DIN = 8192;
constexpr int LDS_BYTES = 144 * 1024;
constexpr size_t MiB = 1u << 20;
constexpr size_t WS_MOD = 1 * MiB;
constexpr size_t WS_LBS = WS_MOD + 256 * 1024;
constexpr size_t WS_DFTP = 2 * MiB;
constexpr size_t WS_WIN = 4 * MiB;
constexpr size_t WS_WPA = 72 * MiB;
constexpr size_t WS_WPB = 80 * MiB;
constexpr size_t WS_WO = 84 * MiB;
constexpr size_t WS_DFTS = 92 * MiB;
constexpr size_t WS_H = 156 * MiB;
constexpr size_t WS_Q = 204 * MiB;
constexpr size_t WS_LF = 252 * MiB;
constexpr size_t WS_LB = 300 * MiB;
constexpr size_t WS_V = 348 * MiB;
constexpr size_t WS_ZA = 396 * MiB;
constexpr size_t WS_ZB = 444 * MiB;
constexpr size_t WS_GA = 468 * MiB;
constexpr size_t WS_GB = 516 * MiB;
constexpr size_t WS_UT = 564 * MiB;
constexpr size_t WS_YAB = 612 * MiB;
constexpr size_t WS_OF = 684 * MiB;
constexpr size_t WS_OB = 780 * MiB;
constexpr size_t WS_SLOC = 876 * MiB;
constexpr size_t WS_LSEG = 1 * MiB + 512 * 1024;
constexpr size_t WS_END = 889 * MiB;
constexpr size_t WS_MERGED = WS_OB;
constexpr size_t UT_SAMPLE_OFF = (size_t)32 * 512 * 512;

struct P {
  const float *x_prompt, *x_sample, *state, *c, *c_ctx, *norm_w, *w_ada, *b_ada, *w_in, *lb_raw, *gnorm_w, *w_pa, *w_pb, *w_o, *final_w;
  float* out; unsigned char* ws;
  unsigned char prog[64];
};

typedef float f32x2v __attribute__((ext_vector_type(2)));
typedef __bf16 bf16x2v __attribute__((ext_vector_type(2)));
__device__ __forceinline__ unsigned pk2(float lo, float hi) { const f32x2v v = {lo, hi}; const bf16x2v b = __builtin_convertvector(v, bf16x2v); return __builtin_bit_cast(unsigned, b); }
__device__ __forceinline__ u16 f2bf(float f) { unsigned u = __float_as_uint(f); u += 0x7FFFu + ((u >> 16) & 1u); return (u16)(u >> 16); }
__device__ __forceinline__ float bf2f(unsigned b) { return __uint_as_float(b << 16); }
__device__ __forceinline__ float bflo(unsigned w) { return __uint_as_float(w << 16); }
__device__ __forceinline__ float bfhi(unsigned w) { return __uint_as_float(w & 0xFFFF0000u); }
__device__ __forceinline__ float h2f(unsigned short h) { return (float)__builtin_bit_cast(_Float16, h); }
__device__ __forceinline__ unsigned short f2h(float f) { return __builtin_bit_cast(unsigned short, (_Float16)f); }
__device__ __forceinline__ float siluf(float x) { return x * __builtin_amdgcn_rcpf(1.f + __expf(-x)); }
__device__ __forceinline__ float sigmf(float x) { return __builtin_amdgcn_rcpf(1.f + __expf(-x)); }
__device__ __forceinline__ float wave_sum(float v) {
#pragma unroll
  for (int o = 1; o < 64; o <<= 1) v += __shfl_xor(v, o);
  return v;
}

namespace pg8 {
constexpr int BM = 256, BK = 64, HALF = 128, HTB = HALF * BK * 2, STAGE_BYTES = 8 * HTB, NXCD = 8, WGM = 4;
__host__ __device__ __forceinline__ int lds_byte(int r, int c) { const int st = (r >> 4) * 2 + (c >> 5), rr = r & 15, cc = c & 31, ob = rr * 64 + cc * 2; return st * 1024 + (ob ^ (((ob >> 9) & 1) << 5)); }
__host__ __device__ __forceinline__ void stage_rc(int b, int& R, int& C) { const int st = b / 1024, sb = b % 1024, swz = sb ^ (((sb >> 9) & 1) << 5); R = (st >> 1) * 16 + swz / 64; C = (st & 1) * 32 + (swz % 64) / 2; }
__host__ __device__ __forceinline__ int perm32(int rho) { const int n = rho >> 4, i = rho & 15; return 8 * (i >> 2) + 4 * n + (i & 3); }
struct Unit { int pm, pn; };
struct Gemm { const u16* A; const u16* Bt; int M, N, K; };
struct StaticOrder {
  int nM, nN, nwg, G, c;
  __device__ void init(int M, int N, int G_, int c_) { nM = M / BM; nN = N / BM; nwg = nM * nN; G = G_; c = c_; }
  __device__ bool next(int i, Unit& u) const {
    const long L = (long)i * G + c; if (c < 0 || L >= nwg) return false;
    int wgid = (int)L; { const int q = nwg / NXCD, r = nwg % NXCD, xcd = wgid % NXCD, off = wgid / NXCD; wgid = (xcd < r ? xcd * (q + 1) : r * (q + 1) + (xcd - r) * q) + off; }
    const int nig = WGM * nN, gid = wgid / nig, fm = gid * WGM, gsz = (nM - fm) < WGM ? (nM - fm) : WGM;
    u.pm = fm + ((wgid % nig) % gsz); u.pn = (wgid % nig) / gsz; return true;
  }
};
template <class Epi>
__device__ __forceinline__ void gemm_phase(LAS unsigned char* lds, const Gemm g, const StaticOrder& S, const Epi& E, const int tid) {
  const int wid = __builtin_amdgcn_readfirstlane(tid >> 6), lane = tid & 63, wr = wid >> 2, wc = wid & 3, fr = lane & 15, fq = lane >> 4;
  const int K = g.K, nt = K / BK;
  unsigned voffA[2], voffB[2];
#pragma unroll
  for (int i = 0; i < 2; ++i) { int R, C; stage_rc(tid * 16 + i * 8192, R, C); const int Rb = E.perm ? ((R & ~31) + perm32(R & 31)) : R;
    voffA[i] = (unsigned)(R * K + C) * 2u; voffB[i] = (unsigned)(Rb * K + C) * 2u; }
  const size_t kstep = (size_t)(BK * 2);
  const size_t hstep = (size_t)HALF * K * 2;
  const size_t tstep = 2 * hstep;
  const unsigned ldsw = (unsigned)wid * 1024u;
  const int aoff = lds_byte(wr * 64 + fr, fq * 8), boff = lds_byte(wc * 32 + fr, fq * 8);
#define PG8_SA(b, h) (((b) * 2 + (h)) * HTB)
#define PG8_SB(b, h) ((4 + (b) * 2 + (h)) * HTB)
#define PG8_STAGE(bufoff, gbase, voff) do { _Pragma("unroll") for (int _i = 0; _i < 2; ++_i) \
    __builtin_amdgcn_global_load_lds((const unsigned*)((const char*)(gbase) + (voff)[_i]), (LAS unsigned*)(lds + (bufoff) + ldsw + _i * 8192), 16, 0, 0); } while (0)
#define PG8_LDA(dst, b, h) do { _Pragma("unroll") for (int m = 0; m < 4; ++m) _Pragma("unroll") for (int k = 0; k < 2; ++k) dst[m][k] = *(const LAS bf16x8*)(lds + PG8_SA(b, h) + aoff + m * 2048 + k * 1024); } while (0)
#define PG8_LDB(dst, b, h) do { _Pragma("unroll") for (int n = 0; n < 2; ++n) _Pragma("unroll") for (int k = 0; k < 2; ++k) dst[n][k] = *(const LAS bf16x8*)(lds + PG8_SB(b, h) + boff + n * 2048 + k * 1024); } while (0)
#define PG8_MMA(ai, bj, At, Bt) do { __builtin_amdgcn_s_setprio(1); _Pragma("unroll") for (int m = 0; m < 4; ++m) _Pragma("unroll") for (int n = 0; n < 2; ++n) _Pragma("unroll") for (int k = 0; k < 2; ++k) \
    acc[ai][bj][m][n] = __builtin_amdgcn_mfma_f32_16x16x32_bf16(Bt[n][k], At[m][k], acc[ai][bj][m][n], 0, 0, 0); __builtin_amdgcn_s_setprio(0); } while (0)
#define PG8_WAIT_V(n) asm volatile("s_waitcnt vmcnt(" #n ")" ::: "memory")
#define PG8_WAIT_L(n) asm volatile("s_waitcnt lgkmcnt(" #n ")" ::: "memory")
#define PG8_BAR __builtin_amdgcn_s_barrier()
#define PG8_SCHED __builtin_amdgcn_sched_barrier(0)
  Unit cur, nxt; int ui = 0;
  if (!S.next(0, cur)) return;
  f32x4 acc[2][2][4][2];
#pragma unroll
  for (int a = 0; a < 2; ++a)
#pragma unroll
    for (int b = 0; b < 2; ++b)
#pragma unroll
      for (int m = 0; m < 4; ++m)
#pragma unroll
        for (int n = 0; n < 2; ++n) acc[a][b][m][n] = (f32x4){0.f, 0.f, 0.f, 0.f};
  bf16x8 At[4][2], B0[2][2], B1[2][2];
  const char* cA = (const char*)g.A + (size_t)cur.pm * tstep; const char* cB = (const char*)g.Bt + (size_t)cur.pn * tstep;
  PG8_STAGE(PG8_SB(0, 0), cB, voffB); PG8_STAGE(PG8_SA(0, 0), cA, voffA); PG8_STAGE(PG8_SB(0, 1), cB + hstep, voffB); PG8_STAGE(PG8_SA(0, 1), cA + hstep, voffA);
  if (wr == 1) PG8_BAR;
  PG8_WAIT_V(4); PG8_BAR;
  PG8_STAGE(PG8_SB(1, 0), cB + kstep, voffB); PG8_STAGE(PG8_SA(1, 0), cA + kstep, voffA); PG8_STAGE(PG8_SB(1, 1), cB + hstep + kstep, voffB);
  PG8_WAIT_V(6); PG8_BAR;
  for (;;) {
    const bool has_next = S.next(ui + 1, nxt);
    const char* nA = has_next ? (const char*)g.A + (size_t)nxt.pm * tstep : cA; const char* nB = has_next ? (const char*)g.Bt + (size_t)nxt.pn * tstep : cB;
    for (int t = 0; t < nt; t += 2) {
      const bool last = (t == nt - 2);
      if (E.type == 2 && t == 16) E.hook(acc, cur, wr, wc, fr, fq);
      const char* a1 = cA + (size_t)(t + 1) * kstep;
      const char* a2 = last ? nA : cA + (size_t)(t + 2) * kstep; const char* b2 = last ? nB : cB + (size_t)(t + 2) * kstep;
      const char* a3 = a2 + kstep; const char* b3 = b2 + kstep;
      PG8_LDB(B0, 0, 0); PG8_SCHED; PG8_LDA(At, 0, 0); PG8_STAGE(PG8_SA(1, 1), a1 + hstep, voffA);
      PG8_WAIT_L(8); PG8_BAR; PG8_WAIT_L(0); PG8_MMA(0, 0, At, B0); PG8_BAR; PG8_SCHED;
      PG8_LDB(B1, 0, 1); PG8_STAGE(PG8_SB(0, 0), b2, voffB);
      PG8_BAR; PG8_WAIT_L(0); PG8_MMA(0, 1, At, B1); PG8_BAR;
      PG8_LDA(At, 0, 1); PG8_STAGE(PG8_SA(0, 0), a2, voffA);
      PG8_BAR; PG8_WAIT_L(0); PG8_MMA(1, 0, At, B0); PG8_BAR; PG8_SCHED;
      PG8_STAGE(PG8_SB(0, 1), b2 + hstep, voffB);
      PG8_WAIT_V(6); PG8_BAR; PG8_MMA(1, 1, At, B1); PG8_BAR;
      PG8_LDB(B0, 1, 0); PG8_SCHED; PG8_LDA(At, 1, 0); PG8_STAGE(PG8_SA(0, 1), a2 + hstep, voffA);
      PG8_WAIT_L(8); PG8_BAR; PG8_WAIT_L(0); PG8_MMA(0, 0, At, B0); PG8_BAR; PG8_SCHED;
      PG8_LDB(B1, 1, 1); PG8_STAGE(PG8_SB(1, 0), b3, voffB);
      PG8_BAR; PG8_WAIT_L(0); PG8_MMA(0, 1, At, B1); PG8_BAR;
      PG8_LDA(At, 1, 1); PG8_STAGE(PG8_SA(1, 0), a3, voffA);
      PG8_BAR; PG8_WAIT_L(0); PG8_MMA(1, 0, At, B0); PG8_BAR; PG8_SCHED;
      PG8_STAGE(PG8_SB(1, 1), b3 + hstep, voffB);
      PG8_WAIT_V(6); PG8_BAR; PG8_MMA(1, 1, At, B1); PG8_BAR;
    }
    E(acc, cur, wr, wc, fr, fq);
    if (!has_next) break;
#pragma unroll
    for (int a = 0; a < 2; ++a)
#pragma unroll
      for (int b = 0; b < 2; ++b)
#pragma unroll
        for (int m = 0; m < 4; ++m)
#pragma unroll
          for (int n = 0; n < 2; ++n) acc[a][b][m][n] = (f32x4){0.f, 0.f, 0.f, 0.f};
    cur = nxt; cA = nA; cB = nB; ++ui;
  }
  PG8_WAIT_V(0);
  if (wr == 0) PG8_BAR;
  PG8_BAR;
#undef PG8_SA
#undef PG8_SB
#undef PG8_STAGE
#undef PG8_LDA
#undef PG8_LDB
#undef PG8_MMA
#undef PG8_WAIT_V
#undef PG8_WAIT_L
#undef PG8_BAR
#undef PG8_SCHED
}
}
using pg8::Unit; using pg8::Gemm; using pg8::StaticOrder;
typedef f32x4 Acc[2][2][4][2];

struct EpiG1 {
  static constexpr bool PERM = true;
  unsigned char* ws; const float* lbs;
  __device__ __forceinline__ void operator()(const Acc& acc, const Unit& u, int wr, int wc, int fr, int fq) const {
    const int pn = u.pn, row0 = u.pm * 256 + wr * 64 + fr;
    if (pn >= 20 && pn < 24) {
      u16* UT = (u16*)(ws + WS_UT);
      const int part = (pn - 20) >> 1;
#pragma unroll
      for (int ai = 0; ai < 2; ++ai)
#pragma unroll
        for (int m = 0; m < 4; ++m) {
          const int r = row0 + ai * 128 + m * 16;
          size_t base; size_t chs;
          if (r < NPROMPT) { const int bp = r >> 8, l = r & 255; base = (size_t)bp * 512 * 512 + part * 256 + l; chs = 512; }
          else { const int rr = r - NPROMPT, b = rr >> 12, l = rr & 4095; base = UT_SAMPLE_OFF + (size_t)b * 512 * 8192 + part * 4096 + l; chs = 8192; }
#pragma unroll
          for (int bj = 0; bj < 2; ++bj) {
            const int ch0 = ((pn - 20) & 1) * 256 + bj * 128 + wc * 32 + 8 * fq;
#pragma unroll
            for (int n = 0; n < 2; ++n)
#pragma unroll
              for (int e = 0; e < 4; e += 2) { const unsigned pr = pk2(acc[ai][bj][m][n][e], acc[ai][bj][m][n][e + 1]);
                UT[base + (size_t)(ch0 + 4 * n + e) * chs] = (u16)(pr & 0xFFFFu); UT[base + (size_t)(ch0 + 4 * n + e + 1) * chs] = (u16)(pr >> 16); }
          }
        }
      return;
    }
    int act, ld = 1024, colt; size_t off;
    if (pn < 4) { act = 1; off = WS_Q; colt = pn * 256; }
    else if (pn < 8) { act = 3; off = WS_LF; colt = (pn - 4) * 256; }
    else if (pn < 12) { act = 4; off = WS_LB; colt = (pn - 8) * 256; }
    else if (pn < 16) { act = 0; off = WS_V; colt = (pn - 12) * 256; }
    else if (pn < 20) { act = 1; off = WS_ZA; colt = (pn - 16) * 256; }
    else if (pn < 26) { act = 1; off = WS_ZB; colt = (pn - 24) * 256; ld = 512; }
    else if (pn < 30) { act = 2; off = WS_GA; colt = (pn - 26) * 256; }
    else { act = 2; off = WS_GB; colt = (pn - 30) * 256; }
    u16* dst = (u16*)(ws + off);
    const int col0 = colt + wc * 32 + 8 * fq;
    f32x4 lbv[2][2];
    if (act >= 3) { const float* lb = lbs + (act == 4 ? 1024 : 0) + col0;
#pragma unroll
      for (int bj = 0; bj < 2; ++bj) { lbv[bj][0] = *(const f32x4*)(lb + bj * 128); lbv[bj][1] = *(const f32x4*)(lb + bj * 128 + 4); } }
#pragma unroll
    for (int ai = 0; ai < 2; ++ai)
#pragma unroll
      for (int m = 0; m < 4; ++m) {
        u16* rowp = dst + (size_t)(row0 + ai * 128 + m * 16) * ld + col0;
#pragma unroll
        for (int bj = 0; bj < 2; ++bj) {
          float v[8];
#pragma unroll
          for (int e = 0; e < 8; ++e) v[e] = acc[ai][bj][m][e >> 2][e & 3];
          u32x4 o;
          if (act >= 3) {
            unsigned short hv[8];
#pragma unroll
            for (int e = 0; e < 8; ++e) { const float oml = 1.f - lbv[bj][e >> 2][e & 3]; const float kk = oml * __builtin_amdgcn_rcpf(1.f + __expf(v[e])); hv[e] = f2h(fmaxf(__log2f(1.f - kk), -57.f)); }
            o[0] = hv[0] | ((unsigned)hv[1] << 16); o[1] = hv[2] | ((unsigned)hv[3] << 16); o[2] = hv[4] | ((unsigned)hv[5] << 16); o[3] = hv[6] | ((unsigned)hv[7] << 16);
          } else {
            if (act == 1) {
#pragma unroll
              for (int e = 0; e < 8; ++e) v[e] = siluf(v[e]);
            } else if (act == 2) {
#pragma unroll
              for (int e = 0; e < 8; ++e) v[e] = sigmf(v[e]);
            }
            o[0] = pk2(v[0], v[1]); o[1] = pk2(v[2], v[3]); o[2] = pk2(v[4], v[5]); o[3] = pk2(v[6], v[7]);
          }
          *(u32x4*)(rowp + bj * 128) = o;
        }
      }
  }
};
struct EpiDFT {
  static constexpr bool PERM = true;
  unsigned char* ws; int rowbase, lshift; float scale;
  __device__ __forceinline__ void operator()(const Acc& acc, const Unit& u, int wr, int wc, int fr, int fq) const {
    const u16* ZB = (const u16*)(ws + WS_ZB); u16* YB = (u16*)(ws + WS_YAB);
    const int k0 = u.pm * 256 + wr * 64 + fr;
    const int n0 = u.pn * 256 + wc * 32 + 8 * fq, b = n0 >> 9, ch0 = n0 & 511;
    const size_t R0 = (size_t)rowbase + ((size_t)b << lshift) + k0;
    const u16* zb = ZB + R0 * 512 + ch0; u16* yb = YB + R0 * 1536 + 1024 + ch0;
#pragma unroll
    for (int ai = 0; ai < 2; ++ai) {
      u32x4 z[4][2];
#pragma unroll
      for (int m = 0; m < 4; ++m)
#pragma unroll
        for (int bj = 0; bj < 2; ++bj) z[m][bj] = *(const u32x4*)(zb + (ai * 128 + m * 16) * 512 + bj * 128);
#pragma unroll
      for (int m = 0; m < 4; ++m)
#pragma unroll
        for (int bj = 0; bj < 2; ++bj) {
          const u32x4 zz = z[m][bj]; u32x4 o;
          o[0] = pk2(acc[ai][bj][m][0][0] * scale * bflo(zz[0]), acc[ai][bj][m][0][1] * scale * bfhi(zz[0]));
          o[1] = pk2(acc[ai][bj][m][0][2] * scale * bflo(zz[1]), acc[ai][bj][m][0][3] * scale * bfhi(zz[1]));
          o[2] = pk2(acc[ai][bj][m][1][0] * scale * bflo(zz[2]), acc[ai][bj][m][1][1] * scale * bfhi(zz[2]));
          o[3] = pk2(acc[ai][bj][m][1][2] * scale * bflo(zz[3]), acc[ai][bj][m][1][3] * scale * bfhi(zz[3]));
          *(u32x4*)(yb + (ai * 128 + m * 16) * 1536 + bj * 128) = o;
        }
      __builtin_amdgcn_sched_barrier(0);
    }
  }
};
struct EpiG2 {
  static constexpr bool PERM = false;
  unsigned char* ws;
  __device__ __forceinline__ void hook(Acc& acc, const Unit& u, int wr, int wc, int fr, int fq) const {
    const u16* GA = (const u16*)(ws + WS_GA); const u16* GB = (const u16*)(ws + WS_GB);
    const int row0 = u.pm * 256 + wr * 64 + fr, col0 = u.pn * 256 + wc * 32 + 4 * fq;
#pragma unroll
    for (int ai = 0; ai < 2; ++ai) {
      u32x2 ga[4][2][2], gb[4][2][2];
#pragma unroll
      for (int m = 0; m < 4; ++m)
#pragma unroll
        for (int bj = 0; bj < 2; ++bj)
#pragma unroll
          for (int n = 0; n < 2; ++n) { const size_t idx = (size_t)(row0 + ai * 128 + m * 16) * 1024 + col0 + bj * 128 + n * 16;
            ga[m][bj][n] = *(const u32x2*)(GA + idx); gb[m][bj][n] = *(const u32x2*)(GB + idx); }
#pragma unroll
      for (int m = 0; m < 4; ++m)
#pragma unroll
        for (int bj = 0; bj < 2; ++bj)
#pragma unroll
          for (int n = 0; n < 2; ++n) { const u32x2 a = ga[m][bj][n], b = gb[m][bj][n]; f32x4& v = acc[ai][bj][m][n];
            v[0] *= bflo(a[0]) * __builtin_amdgcn_rcpf(fmaxf(bflo(b[0]), 1e-30f)); v[1] *= bfhi(a[0]) * __builtin_amdgcn_rcpf(fmaxf(bfhi(b[0]), 1e-30f));
            v[2] *= bflo(a[1]) * __builtin_amdgcn_rcpf(fmaxf(bflo(b[1]), 1e-30f)); v[3] *= bfhi(a[1]) * __builtin_amdgcn_rcpf(fmaxf(bfhi(b[1]), 1e-30f)); }
      __builtin_amdgcn_sched_barrier(0);
    }
  }
  __device__ __forceinline__ void operator()(const Acc& acc, const Unit& u, int wr, int wc, int fr, int fq) const {
    const u16* GB = (const u16*)(ws + WS_GB); u16* MG = (u16*)(ws + WS_MERGED);
    const int row0 = u.pm * 256 + wr * 64 + fr, col0 = u.pn * 256 + wc * 32 + 4 * fq;
#pragma unroll
    for (int ai = 0; ai < 2; ++ai) {
      u32x2 gb[4][2][2];
#pragma unroll
      for (int m = 0; m < 4; ++m)
#pragma unroll
        for (int bj = 0; bj < 2; ++bj)
#pragma unroll
          for (int n = 0; n < 2; ++n) gb[m][bj][n] = *(const u32x2*)(GB + (size_t)(row0 + ai * 128 + m * 16) * 1024 + col0 + bj * 128 + n * 16);
#pragma unroll
      for (int m = 0; m < 4; ++m)
#pragma unroll
        for (int bj = 0; bj < 2; ++bj)
#pragma unroll
          for (int n = 0; n < 2; ++n) { const u32x2 b = gb[m][bj][n]; const f32x4 v = acc[ai][bj][m][n];
            u32x2 o; o[0] = pk2(v[0] * bflo(b[0]), v[1] * bfhi(b[0])); o[1] = pk2(v[2] * bflo(b[1]), v[3] * bfhi(b[1]));
            *(u32x2*)(MG + (size_t)(row0 + ai * 128 + m * 16) * 1024 + col0 + bj * 128 + n * 16) = o; }
      __builtin_amdgcn_sched_barrier(0);
    }
  }
};
struct EpiG3 {
  static constexpr bool PERM = false;
  float* x; const float* modl;
  __device__ __forceinline__ void operator()(const Acc& acc, const Unit& u, int wr, int wc, int fr, int fq) const {
    const int j = u.pm < 32 ? 0 : 1 + ((u.pm - 32) >> 4);
    const float* gt = modl + j * 3072 + 2048;
    const int row0 = u.pm * 256 + wr * 64 + fr, col0 = u.pn * 256 + wc * 32 + 4 * fq;
    f32x4 gv[2][2];
#pragma unroll
    for (int bj = 0; bj < 2; ++bj)
#pragma unroll
      for (int n = 0; n < 2; ++n) gv[bj][n] = *(const f32x4*)(gt + col0 + bj * 128 + n * 16);
#pragma unroll
    for (int ai = 0; ai < 2; ++ai)
#pragma unroll
      for (int mp = 0; mp < 2; ++mp) {
        f32x4 xv[2][2][2];
#pragma unroll
        for (int mi = 0; mi < 2; ++mi)
#pragma unroll
          for (int bj = 0; bj < 2; ++bj)
#pragma unroll
            for (int n = 0; n < 2; ++n) xv[mi][bj][n] = *(const f32x4*)(x + (size_t)(row0 + ai * 128 + (2 * mp + mi) * 16) * 1024 + col0 + bj * 128 + n * 16);
#pragma unroll
        for (int mi = 0; mi < 2; ++mi)
#pragma unroll
          for (int bj = 0; bj < 2; ++bj)
#pragma unroll
            for (int n = 0; n < 2; ++n) *(f32x4*)(x + (size_t)(row0 + ai * 128 + (2 * mp + mi) * 16) * 1024 + col0 + bj * 128 + n * 16) = xv[mi][bj][n] + gv[bj][n] * acc[ai][bj][2 * mp + mi][n];
        __builtin_amdgcn_sched_barrier(0);
      }
  }
};

__device__ __forceinline__ void p0_prologue(const P& p, unsigned char* shm, const int tid) {
  const int bid = blockIdx.x, G = gridDim.x;
  float* fs = (float*)shm;
  for (int i = bid * 512 + tid; i < 2048; i += G * 512) {
    float r[4], mx = -1e30f;
    for (int l = 0; l < 4; ++l) { r[l] = p.lb_raw[l * 2048 + i]; mx = fmaxf(mx, r[l]); }
    float s = 0.f; for (int l = 0; l < 4; ++l) { r[l] = expf(r[l] - mx); s += r[l]; }
    float cs = 0.f; float* lbs = (float*)(p.ws + WS_LBS);
    for (int l = 0; l < 4; ++l) { if (l > 0) cs += r[l] / s; lbs[l * 2048 + i] = cs; }
  }
  for (int it = bid; it < 96; it += G) {
    const int l = it / 24, n0 = (it % 24) * 128;
    for (int i = tid; i < 5120; i += 512) { const int j = i >> 10, k = i & 1023; const float cv = j == 0 ? p.c_ctx[k] : p.c[(j - 1) * 1024 + k]; fs[i] = cv / (1.f + expf(-cv)); }
    __syncthreads();
    const int col = tid & 127, kq = tid >> 7;
    float a[5] = {0.f, 0.f, 0.f, 0.f, 0.f};
    const float* w = p.w_ada + ((size_t)l * 1024 + kq * 256) * 3072 + n0 + col;
    for (int k = 0; k < 256; k += 32) {
      float wv[32];
#pragma unroll
      for (int u = 0; u < 32; ++u) wv[u] = w[(size_t)(k + u) * 3072];
#pragma unroll
      for (int u = 0; u < 32; ++u)
#pragma unroll
        for (int j = 0; j < 5; ++j) a[j] += fs[j * 1024 + kq * 256 + k + u] * wv[u];
    }
    __syncthreads();
#pragma unroll
    for (int j = 0; j < 5; ++j) fs[5120 + (kq * 5 + j) * 128 + col] = a[j];
    __syncthreads();
    if (tid < 128) {
      float* modv = (float*)(p.ws + WS_MOD);
#pragma unroll
      for (int j = 0; j < 5; ++j) { const float s = fs[5120 + (0 * 5 + j) * 128 + tid] + fs[5120 + (1 * 5 + j) * 128 + tid] + fs[5120 + (2 * 5 + j) * 128 + tid] + fs[5120 + (3 * 5 + j) * 128 + tid];
        modv[((size_t)l * 5 + j) * 3072 + n0 + tid] = s + p.b_ada[l * 3072 + n0 + tid]; }
    }
    __syncthreads();
  }
  for (int it = bid; it < 256; it += G) {
    const int l = it >> 6, g = (it >> 4) & 3, k0 = (it & 15) * 64;
    for (int i = tid; i < 64 * 32; i += 512) { const int kk = i >> 5, c4 = (i & 31) * 4;
      const f32x4 v = *(const f32x4*)(p.w_in + ((size_t)l * 1024 + k0 + kk) * DIN + 5120 + g * 128 + c4);
      fs[(c4 + 0) * 68 + kk] = v[0]; fs[(c4 + 1) * 68 + kk] = v[1]; fs[(c4 + 2) * 68 + kk] = v[2]; fs[(c4 + 3) * 68 + kk] = v[3]; }
    __syncthreads();
    const int m = tid & 127, kq = tid >> 7;
    float sm, cm; sincospif((float)m / 64.f, &sm, &cm);
    float cr = 1.f, sr = 0.f, ac[16], as[16];
#pragma unroll
    for (int i = 0; i < 16; ++i) { ac[i] = 0.f; as[i] = 0.f; }
    for (int c = 0; c < 128; ++c) {
      const float* wrow = fs + c * 68 + kq * 16;
#pragma unroll
      for (int i4 = 0; i4 < 4; ++i4) { const f32x4 wv = *(const f32x4*)(wrow + i4 * 4);
#pragma unroll
        for (int e = 0; e < 4; ++e) { ac[i4 * 4 + e] += wv[e] * cr; as[i4 * 4 + e] -= wv[e] * sr; } }
      const float c2 = cr * cm - sr * sm, s2 = sr * cm + cr * sm; cr = c2; sr = s2;
    }
    u16* WIN = (u16*)(p.ws + WS_WIN) + (size_t)l * NG1 * 1024;
    u32x4 o0, o1, o2, o3;
    o0[0] = pk2(ac[0], ac[1]); o0[1] = pk2(ac[2], ac[3]); o0[2] = pk2(ac[4], ac[5]); o0[3] = pk2(ac[6], ac[7]);
    o1[0] = pk2(ac[8], ac[9]); o1[1] = pk2(ac[10], ac[11]); o1[2] = pk2(ac[12], ac[13]); o1[3] = pk2(ac[14], ac[15]);
    o2[0] = pk2(as[0], as[1]); o2[1] = pk2(as[2], as[3]); o2[2] = pk2(as[4], as[5]); o2[3] = pk2(as[6], as[7]);
    o3[0] = pk2(as[8], as[9]); o3[1] = pk2(as[10], as[11]); o3[2] = pk2(as[12], as[13]); o3[3] = pk2(as[14], as[15]);
    u16* dc = WIN + (size_t)(5120 + g * 128 + m) * 1024 + k0 + kq * 16;
    u16* ds = WIN + (size_t)(5120 + 512 + g * 128 + m) * 1024 + k0 + kq * 16;
    *(u32x4*)dc = o0; *(u32x4*)(dc + 8) = o1; *(u32x4*)ds = o2; *(u32x4*)(ds + 8) = o3;
    __syncthreads();
  }
  {
    constexpr int I_IN = 16 * 120, I_PA = 16 * 16, I_PB = 8 * 16, I_O = 16 * 16, I_L = I_IN + I_PA + I_PB + I_O;
    for (int it0 = bid; it0 < 4 * I_L; it0 += 4 * G) {
#pragma unroll
      for (int q = 0; q < 4; ++q) {
        const int it = it0 + q * G; if (it >= 4 * I_L) break;
        const int l = it / I_L; int r = it % I_L;
        const float* W; int Nsrc, kb, nsrc0;
        if (r < I_IN) { kb = r / 120; const int nb = r % 120; nsrc0 = nb * 64 + (nb * 64 >= 5120 ? 512 : 0); W = p.w_in + (size_t)l * 1024 * DIN; Nsrc = DIN; }
        else if ((r -= I_IN) < I_PA) { kb = r / 16; nsrc0 = (r % 16) * 64; W = p.w_pa + (size_t)l * 1024 * 1024; Nsrc = 1024; }
        else if ((r -= I_PA) < I_PB) { kb = r / 16; nsrc0 = (r % 16) * 64; W = p.w_pb + (size_t)l * 512 * 1024; Nsrc = 1024; }
        else { r -= I_PB; kb = r / 16; nsrc0 = (r % 16) * 64; W = p.w_o + (size_t)l * 1024 * 1024; Nsrc = 1024; }
        const int k0 = kb * 64;
#pragma unroll
        for (int ps = 0; ps < 8; ++ps) { const int kk = ps * 8 + (tid >> 6), nn = tid & 63; fs[q * 4160 + kk * 65 + nn] = W[(size_t)(k0 + kk) * Nsrc + nsrc0 + nn]; }
      }
      __syncthreads();
#pragma unroll
      for (int q = 0; q < 4; ++q) {
        const int it = it0 + q * G; if (it >= 4 * I_L) break;
        const int l = it / I_L; int r = it % I_L;
        u16* WT; int Kd, kb, ndst0;
        if (r < I_IN) { kb = r / 120; const int nb = r % 120; ndst0 = nb * 64; if (ndst0 >= 5120) ndst0 += 1024; WT = (u16*)(p.ws + WS_WIN) + (size_t)l * NG1 * 1024; Kd = 1024; }
        else if ((r -= I_IN) < I_PA) { kb = r / 16; ndst0 = (r % 16) * 64; WT = (u16*)(p.ws + WS_WPA) + (size_t)l * 1024 * 1536; Kd = 1536; }
        else if ((r -= I_PA) < I_PB) { kb = r / 16; ndst0 = (r % 16) * 64; WT = (u16*)(p.ws + WS_WPA) + (size_t)l * 1024 * 1536 + 1024; Kd = 1536; }
        else { r -= I_PB; kb = r / 16; ndst0 = (r % 16) * 64; WT = (u16*)(p.ws + WS_WO) + (size_t)l * 1024 * 1024; Kd = 1024; }
        const int k0 = kb * 64;
        const int nn = tid >> 3, kc = tid & 7; const float* sp = fs + q * 4160 + (8 * kc) * 65 + nn;
        u32x4 o; o[0] = pk2(sp[0], sp[65]); o[1] = pk2(sp[2 * 65], sp[3 * 65]); o[2] = pk2(sp[4 * 65], sp[5 * 65]); o[3] = pk2(sp[6 * 65], sp[7 * 65]);
        *(u32x4*)(WT + (size_t)(ndst0 + nn) * Kd + k0 + 8 * kc) = o;
      }
      __syncthreads();
    }
  }
  {
    __syncthreads();
    for (int r = tid; r < 4096; r += 512) { float sv, cv; sincospif((float)r * (1.f / 2048.f), &sv, &cv); fs[r] = cv; fs[4096 + r] = sv; }
    __syncthreads();
    u16* DS = (u16*)(p.ws + WS_DFTS);
    for (size_t i = (size_t)bid * 512 + tid; i < (size_t)4096 * 512; i += (size_t)G * 512) {
      const int k = (int)(i >> 9), j0 = (int)(i & 511) * 8; const int part = j0 >> 11, jj = j0 & 2047;
      const float* tb = fs + part * 4096;
      float v[8];
#pragma unroll
      for (int e = 0; e < 8; ++e) v[e] = tb[(k * (jj + e)) & 4095];
      if (part == 1 && jj == 0) v[0] = (k & 1) ? -1.f : 1.f;
      u32x4 o; o[0] = pk2(v[0], v[1]); o[1] = pk2(v[2], v[3]); o[2] = pk2(v[4], v[5]); o[3] = pk2(v[6], v[7]);
      *(u32x4*)(DS + (size_t)k * 4096 + j0) = o;
    }
    u16* DP = (u16*)(p.ws + WS_DFTP);
    for (int i = bid * 512 + tid; i < 256 * 64; i += G * 512) {
      const int k = i >> 6, j0 = (i & 63) * 8; const int part = j0 >> 8, jj = j0 & 255;
      const float* tb = fs + part * 4096;
      float v[8];
#pragma unroll
      for (int e = 0; e < 8; ++e) v[e] = tb[((k * (jj + e)) & 255) * 16];
      u32x4 o; o[0] = pk2(v[0], v[1]); o[1] = pk2(v[2], v[3]); o[2] = pk2(v[4], v[5]); o[3] = pk2(v[6], v[7]);
      *(u32x4*)(DP + (size_t)k * 512 + j0) = o;
    }
  }
}

__device__ __forceinline__ void phase_fold(const P& p, const int tid) {
  const u16* UT = (const u16*)(p.ws + WS_UT) + UT_SAMPLE_OFF; u16* UF = (u16*)(p.ws + WS_H);
  for (int it = blockIdx.x * 512 + tid; it < 2048 * 512; it += gridDim.x * 512) {
    const int n = it >> 9, c = it & 511, part = c >> 8, cc = c & 255;
    const u16* base = UT + (size_t)n * 8192 + part * 4096;
    const u32x4 f = *(const u32x4*)(base + 8 * cc), g = *(const u32x4*)(base + 4096 - 8 * cc - 8);
    float fw[8], bw[8];
#pragma unroll
    for (int e = 0; e < 4; ++e) { fw[2 * e] = bflo(f[e]); fw[2 * e + 1] = bfhi(f[e]); }
    float gv[8];
#pragma unroll
    for (int e = 0; e < 4; ++e) { gv[2 * e] = bflo(g[e]); gv[2 * e + 1] = bfhi(g[e]); }
#pragma unroll
    for (int e = 1; e < 8; ++e) bw[e] = gv[8 - e];
    bw[0] = cc ? bf2f(base[4096 - 8 * cc]) : 0.f;
    float o[8];
#pragma unroll
    for (int e = 0; e < 8; ++e) o[e] = part ? fw[e] - bw[e] : fw[e] + bw[e];
    if (cc == 0) o[0] = part ? bf2f(UT[(size_t)n * 8192 + 2048]) : fw[0];
    u32x4 ov; ov[0] = pk2(o[0], o[1]); ov[1] = pk2(o[2], o[3]); ov[2] = pk2(o[4], o[5]); ov[3] = pk2(o[6], o[7]);
    *(u32x4*)(UF + (size_t)n * 4096 + part * 2048 + 8 * cc) = ov;
  }
}

__device__ __forceinline__ void phase_h(const P& p, int l, bool first, const int tid) {
  const int lane = tid & 63, gw = blockIdx.x * 8 + (tid >> 6), ngw = gridDim.x * 8;
  const float* modl = (const float*)(p.ws + WS_MOD) + (size_t)l * 5 * 3072;
  u16* H = (u16*)(p.ws + WS_H);
  float pef[4] = {0.f, 0.f, 0.f, 0.f};
  if (first) {
#pragma unroll
    for (int e = 0; e < 4; ++e) pef[e] = 1.0f / powf(10000.0f, (float)(4 * lane + e) / 256.0f);
  }
  for (int r = gw; r < NTOK; r += ngw) {
    const int j = r < NPROMPT ? 0 : 1 + ((r - NPROMPT) >> 12);
    float* xr = p.out + (size_t)r * 1024;
    f32x4 v[4];
    if (first) {
      const float* src = r < NPROMPT ? p.x_prompt + (size_t)r * 1024 : p.x_sample + (size_t)(r - NPROMPT) * 1024;
#pragma unroll
      for (int i = 0; i < 4; ++i) v[i] = *(const f32x4*)(src + 4 * (lane + 64 * i));
      if (r >= NPROMPT) {
        const int pos = (r - NPROMPT) & 4095; const float pr = (float)(pos >> 6), pc = (float)(pos & 63);
#pragma unroll
        for (int e = 0; e < 4; ++e) {
          const float fr_ = pef[e];
          v[0][e] += sinf(pr * fr_); v[1][e] += cosf(pr * fr_); v[2][e] += sinf(pc * fr_); v[3][e] += cosf(pc * fr_);
        }
      }
#pragma unroll
      for (int i = 0; i < 4; ++i) *(f32x4*)(xr + 4 * (lane + 64 * i)) = v[i];
    } else {
#pragma unroll
      for (int i = 0; i < 4; ++i) v[i] = *(const f32x4*)(xr + 4 * (lane + 64 * i));
    }
    float ss = 0.f;
#pragma unroll
    for (int i = 0; i < 4; ++i) ss += (v[i][0] * v[i][0] + v[i][1] * v[i][1]) + (v[i][2] * v[i][2] + v[i][3] * v[i][3]);
    const float rstd = rsqrtf(wave_sum(ss) * (1.f / 1024.f) + 1e-6f);
#pragma unroll
    for (int i = 0; i < 4; ++i) {
      const int e0 = 4 * (lane + 64 * i);
      const f32x4 nw = *(const f32x4*)(p.norm_w + l * 1024 + e0), sh = *(const f32x4*)(modl + j * 3072 + e0), sc = *(const f32x4*)(modl + j * 3072 + 1024 + e0);
      f32x4 hh;
#pragma unroll
      for (int e = 0; e < 4; ++e) hh[e] = (v[i][e] * rstd) * nw[e] * (1.f + sc[e]) + sh[e];
      u32x2 o; o[0] = pk2(hh[0], hh[1]); o[1] = pk2(hh[2], hh[3]);
      *(u32x2*)(H + (size_t)r * 1024 + e0) = o;
    }
  }
}

constexpr int SC_QB = 0, SC_KB = 8704, SC_KLT = 17408, SC_DEC = 26624, SC_EM = 27136, SC_P = 27648, SC_QA = 29184, SC_BUF = 37888;
__device__ __forceinline__ float ex2(float x) { return __builtin_amdgcn_exp2f(x); }
__device__ __forceinline__ void scan_chain(const P& p, int l, int seq, int hh, int dir, int mode, int seg, unsigned char* shm, int& parity, const int tid) {
  const int w = tid >> 6, lane = tid & 63, fr = lane & 15, fq = lane >> 4;
  const bool samp = seq >= 32;
  const int L = samp ? 4096 : 256, rowbase = samp ? NPROMPT + (seq - 32) * 4096 : seq * 256, nch = mode ? 32 : (L >> 5), n0 = mode ? seg * 32 : 0;
  const int chain = (seq - 32) * 16 + hh * 2 + dir;
  const long cstep = dir ? -32 * 1024 : 32 * 1024;
  const long rstr = dir ? -1024 : 1024;
  const size_t e0 = (size_t)((long)((size_t)rowbase + (dir ? L - 1 : 0)) * 1024 + hh * 128 + (long)n0 * cstep);
  const u16* Qc = (const u16*)(p.ws + WS_Q) + e0;
  const u16* LFc = (const u16*)(p.ws + (dir ? WS_LB : WS_LF)) + e0;
  const u16* Vc = (const u16*)(p.ws + WS_V) + e0;
  u16* Oc = (u16*)(p.ws + (dir ? WS_OB : WS_OF)) + e0;
  const int sg = dir ? -1 : 1;
  const int off_t = sg * (fq * 8) * 1024 + w * 16 + fr;
  const int off_c0 = sg * fr * 1024 + w * 16 + fq * 4;
  const int off_v = sg * (fq * 4) * 1024 + w * 16 + fr;
  f32x4 S[8];
  if (mode == 1 || !samp) {
#pragma unroll
    for (int cb = 0; cb < 8; ++cb) S[cb] = (f32x4){0.f, 0.f, 0.f, 0.f};
  } else {
    const float* s0 = p.state + ((((size_t)(seq - 32) * 4 + l) * 2 + dir) * 8 + hh) * 16384 + w * 16 + fr;
#pragma unroll
    for (int cb = 0; cb < 8; ++cb)
#pragma unroll
      for (int j = 0; j < 4; ++j) S[cb][j] = s0[(cb * 16 + fq * 4 + j) * 128];
    for (int g = 0; g < seg; ++g) {
      const float* sl = (const float*)(p.ws + WS_SLOC) + ((size_t)chain * 3 + g) * 16384 + w * 16 + fr;
      const float* lg = (const float*)(p.ws + WS_LSEG) + ((size_t)chain * 3 + g) * 128 + fq * 4;
#pragma unroll
      for (int cb = 0; cb < 8; ++cb) { const f32x4 lv4 = *(const f32x4*)(lg + cb * 16);
#pragma unroll
        for (int j = 0; j < 4; ++j) S[cb][j] = ex2(lv4[j]) * S[cb][j] + sl[(cb * 16 + fq * 4 + j) * 128]; }
    }
  }
  f32x4 lsum = {0.f, 0.f, 0.f, 0.f};
  bf16x8 Lm[2];
#pragma unroll
  for (int tb = 0; tb < 2; ++tb)
#pragma unroll
    for (int j = 0; j < 8; ++j) Lm[tb][j] = (fq * 8 + j <= tb * 16 + fr) ? (short)0x3F80 : (short)0;
  u16 n_lft[8], n_v[8]; u32x2 n_lfc[2], n_qc[2] = {{0u, 0u}, {0u, 0u}};
#define SC_LOAD(QP, LP, VP) do { \
    _Pragma("unroll") for (int j = 0; j < 8; ++j) n_lft[j] = ((LP) + j * rstr)[off_t]; \
    _Pragma("unroll") for (int tb = 0; tb < 2; ++tb) { n_lfc[tb] = *(const u32x2*)((LP) + tb * 16 * rstr + off_c0); if (mode != 1) n_qc[tb] = *(const u32x2*)((QP) + tb * 16 * rstr + off_c0); } \
    _Pragma("unroll") for (int i = 0; i < 8; ++i) n_v[i] = ((VP) + ((i >> 2) * 16 + (i & 3)) * rstr)[off_v]; } while (0)
  SC_LOAD(Qc, LFc, Vc);
  for (int n = 0; n < nch; ++n) {
    u16 lft[8], vv[8]; u32x2 lfc[2], qc[2];
#pragma unroll
    for (int j = 0; j < 8; ++j) { lft[j] = n_lft[j]; vv[j] = n_v[j]; }
    lfc[0] = n_lfc[0]; lfc[1] = n_lfc[1]; qc[0] = n_qc[0]; qc[1] = n_qc[1];
    u16* Ocur = Oc;
    Qc += cstep; LFc += cstep; Vc += cstep; Oc += cstep;
    if (n + 1 < nch) SC_LOAD(Qc, LFc, Vc);
    unsigned char* buf = shm + (parity & 1) * SC_BUF; parity ^= 1;
    bf16x8 ahi, alo, vop;
    {
      unsigned hb[8], lb2[8];
#pragma unroll
      for (int j = 0; j < 8; ++j) { const float x = h2f(lft[j]); const unsigned xb = __float_as_uint(x) & 0xFFFF0000u; hb[j] = xb; lb2[j] = __float_as_uint(x - __uint_as_float(xb)); }
      u32x4 ph, pl, pv;
#pragma unroll
      for (int j = 0; j < 4; ++j) { ph[j] = (hb[2 * j] >> 16) | hb[2 * j + 1]; pl[j] = (lb2[2 * j] >> 16) | (lb2[2 * j + 1] & 0xFFFF0000u); pv[j] = (unsigned)vv[2 * j] | ((unsigned)vv[2 * j + 1] << 16); }
      ahi = __builtin_bit_cast(bf16x8, ph); alo = __builtin_bit_cast(bf16x8, pl); vop = __builtin_bit_cast(bf16x8, pv);
    }
    f32x4 b[2];
#pragma unroll
    for (int tb = 0; tb < 2; ++tb) {
      b[tb] = __builtin_amdgcn_mfma_f32_16x16x32_bf16(ahi, Lm[tb], (f32x4){0.f, 0.f, 0.f, 0.f}, 0, 0, 0);
      b[tb] = __builtin_amdgcn_mfma_f32_16x16x32_bf16(alo, Lm[tb], b[tb], 0, 0, 0);
    }
    f32x4 blast, bmid, elm, emc;
#pragma unroll
    for (int j = 0; j < 4; ++j) { blast[j] = __shfl(b[1][j], (lane & 48) | 15); bmid[j] = __shfl(b[0][j], (lane & 48) | 15); elm[j] = ex2(blast[j] - bmid[j]); emc[j] = ex2(bmid[j]); }
    lsum += blast;
#pragma unroll
    for (int tb = 0; tb < 2; ++tb) {
      float qv[4], lv[4], qb[4], kb[4], kl[4];
      qv[0] = bflo(qc[tb][0]); qv[1] = bfhi(qc[tb][0]); qv[2] = bflo(qc[tb][1]); qv[3] = bfhi(qc[tb][1]);
      lv[0] = h2f((u16)(lfc[tb][0] & 0xFFFF)); lv[1] = h2f((u16)(lfc[tb][0] >> 16)); lv[2] = h2f((u16)(lfc[tb][1] & 0xFFFF)); lv[3] = h2f((u16)(lfc[tb][1] >> 16));
#pragma unroll
      for (int j = 0; j < 4; ++j) { const float kk = 1.f - ex2(lv[j]), d = b[tb][j] - bmid[j]; qb[j] = qv[j] * ex2(d); kb[j] = kk * ex2(-d); kl[j] = kb[j] * elm[j]; }
      if (mode != 1) {
        u32x2 o; o[0] = pk2(qb[0], qb[1]); o[1] = pk2(qb[2], qb[3]);
        *(u32x2*)(buf + SC_QB + (tb * 16 + fr) * 272 + (w * 16 + fq * 4) * 2) = o;
        o[0] = pk2(qb[0] * emc[0], qb[1] * emc[1]); o[1] = pk2(qb[2] * emc[2], qb[3] * emc[3]);
        *(u32x2*)(buf + SC_QA + (tb * 16 + fr) * 272 + (w * 16 + fq * 4) * 2) = o;
        o[0] = pk2(kb[0], kb[1]); o[1] = pk2(kb[2], kb[3]);
        *(u32x2*)(buf + SC_KB + (tb * 16 + fr) * 272 + (w * 16 + fq * 4) * 2) = o;
      }
      const unsigned k01 = pk2(kl[0], kl[1]), k23 = pk2(kl[2], kl[3]);
      unsigned char* kp = buf + SC_KLT + (w * 16 + fq * 4) * 72 + (tb * 16 + fr) * 2;
      *(u16*)(kp) = (u16)(k01 & 0xFFFFu); *(u16*)(kp + 72) = (u16)(k01 >> 16); *(u16*)(kp + 144) = (u16)(k23 & 0xFFFFu); *(u16*)(kp + 216) = (u16)(k23 >> 16);
    }
    if (fr == 0) { f32x4 d;
#pragma unroll
      for (int j = 0; j < 4; ++j) d[j] = emc[j] * elm[j];
      *(f32x4*)(buf + SC_DEC + (w * 16 + fq * 4) * 4) = d; }
    __syncthreads();
    f32x4 o0 = {0.f, 0.f, 0.f, 0.f}, o1 = o0;
    if (mode != 1) {
      if (w < 3) {
        const int krow = (w == 2 ? 16 : 0) + fr, qrow = (w == 0 ? 0 : 16) + fr;
        f32x4 at = {0.f, 0.f, 0.f, 0.f};
#pragma unroll
        for (int kbk = 0; kbk < 4; ++kbk) {
          const bf16x8 kf = *(const bf16x8*)(buf + SC_KB + krow * 272 + kbk * 64 + fq * 16), qf = *(const bf16x8*)(buf + SC_QB + qrow * 272 + kbk * 64 + fq * 16);
          at = __builtin_amdgcn_mfma_f32_16x16x32_bf16(kf, qf, at, 0, 0, 0);
        }
        if (w != 1) {
#pragma unroll
          for (int j = 0; j < 4; ++j) at[j] = (fq * 4 + j <= fr) ? at[j] : 0.f;
        }
        u32x2 pw; pw[0] = pk2(at[0], at[1]); pw[1] = pk2(at[2], at[3]);
        *(u32x2*)(buf + SC_P + w * 512 + lane * 8) = pw;
      }
#pragma unroll
      for (int kbk = 0; kbk < 4; ++kbk) {
        u32x4 sp; sp[0] = pk2(S[2 * kbk][0], S[2 * kbk][1]); sp[1] = pk2(S[2 * kbk][2], S[2 * kbk][3]); sp[2] = pk2(S[2 * kbk + 1][0], S[2 * kbk + 1][1]); sp[3] = pk2(S[2 * kbk + 1][2], S[2 * kbk + 1][3]);
        const bf16x8 sop = __builtin_bit_cast(bf16x8, sp);
        u32x4 qa, qb2;
        { const u32x2 x0 = *(const u32x2*)(buf + SC_QA + fr * 272 + kbk * 64 + fq * 8), x1 = *(const u32x2*)(buf + SC_QA + fr * 272 + kbk * 64 + 32 + fq * 8); qa[0] = x0[0]; qa[1] = x0[1]; qa[2] = x1[0]; qa[3] = x1[1]; }
        { const u32x2 x0 = *(const u32x2*)(buf + SC_QA + (16 + fr) * 272 + kbk * 64 + fq * 8), x1 = *(const u32x2*)(buf + SC_QA + (16 + fr) * 272 + kbk * 64 + 32 + fq * 8); qb2[0] = x0[0]; qb2[1] = x0[1]; qb2[2] = x1[0]; qb2[3] = x1[1]; }
        o0 = __builtin_amdgcn_mfma_f32_16x16x32_bf16(__builtin_bit_cast(bf16x8, qa), sop, o0, 0, 0, 0);
        o1 = __builtin_amdgcn_mfma_f32_16x16x32_bf16(__builtin_bit_cast(bf16x8, qb2), sop, o1, 0, 0, 0);
      }
    }
#pragma unroll
    for (int cb = 0; cb < 8; ++cb) {
      const f32x4 d = *(const f32x4*)(buf + SC_DEC + (cb * 16 + fq * 4) * 4);
      u32x4 ka; { const u32x2 x0 = *(const u32x2*)(buf + SC_KLT + (cb * 16 + fr) * 72 + fq * 8), x1 = *(const u32x2*)(buf + SC_KLT + (cb * 16 + fr) * 72 + 32 + fq * 8); ka[0] = x0[0]; ka[1] = x0[1]; ka[2] = x1[0]; ka[3] = x1[1]; }
      S[cb] = __builtin_amdgcn_mfma_f32_16x16x32_bf16(__builtin_bit_cast(bf16x8, ka), vop, d * S[cb], 0, 0, 0);
    }
    if (mode != 1) {
      __syncthreads();
      const u32x2 t0 = *(const u32x2*)(buf + SC_P + lane * 8), t1 = *(const u32x2*)(buf + SC_P + 512 + lane * 8), t2 = *(const u32x2*)(buf + SC_P + 1024 + lane * 8);
      u32x4 pp; pp[0] = t0[0]; pp[1] = t0[1]; pp[2] = 0u; pp[3] = 0u;
      o0 = __builtin_amdgcn_mfma_f32_16x16x32_bf16(__builtin_bit_cast(bf16x8, pp), vop, o0, 0, 0, 0);
      pp[0] = t1[0]; pp[1] = t1[1]; pp[2] = t2[0]; pp[3] = t2[1];
      o1 = __builtin_amdgcn_mfma_f32_16x16x32_bf16(__builtin_bit_cast(bf16x8, pp), vop, o1, 0, 0, 0);
#pragma unroll
      for (int j = 0; j < 4; j += 2) { const unsigned a = pk2(o0[j], o0[j + 1]), b = pk2(o1[j], o1[j + 1]);
        (Ocur + j * rstr)[off_v] = (u16)(a & 0xFFFFu); (Ocur + (j + 1) * rstr)[off_v] = (u16)(a >> 16); (Ocur + (16 + j) * rstr)[off_v] = (u16)(b & 0xFFFFu); (Ocur + (17 + j) * rstr)[off_v] = (u16)(b >> 16); }
    }
  }
#undef SC_LOAD
  if (mode == 1) {
    float* sl = (float*)(p.ws + WS_SLOC) + ((size_t)chain * 3 + seg) * 16384 + w * 16 + fr;
#pragma unroll
    for (int cb = 0; cb < 8; ++cb)
#pragma unroll
      for (int j = 0; j < 4; ++j) sl[(cb * 16 + fq * 4 + j) * 128] = S[cb][j];
    if (fr == 0) *(f32x4*)((float*)(p.ws + WS_LSEG) + ((size_t)chain * 3 + seg) * 128 + w * 16 + fq * 4) = lsum;
  }
  if (!samp) {
    float* ns = p.out + (size_t)NTOK * 1024 + ((((size_t)seq * 4 + l) * 2 + dir) * 8 + hh) * 16384 + w * 16 + fr;
#pragma unroll
    for (int cb = 0; cb < 8; ++cb)
#pragma unroll
      for (int j = 0; j < 4; ++j) ns[(cb * 16 + fq * 4 + j) * 128] = S[cb][j];
  }
}

__device__ __forceinline__ void phase_fin(const P& p, int l, const int tid) {
  const int lane = tid & 63, gw = blockIdx.x * 8 + (tid >> 6), ngw = gridDim.x * 8;
  const u16* OF = (const u16*)(p.ws + WS_OF); const u16* OB = (const u16*)(p.ws + WS_OB);
  const u16* ZA = (const u16*)(p.ws + WS_ZA); u16* YA = (u16*)(p.ws + WS_YAB);
  const float* gw_ = p.gnorm_w + l * 1024 + lane * 16;
  for (int r = gw; r < NTOK; r += ngw) {
    const size_t base = (size_t)r * 1024 + lane * 16;
    const u32x4 f0 = *(const u32x4*)(OF + base), f1 = *(const u32x4*)(OF + base + 8), b0 = *(const u32x4*)(OB + base), b1 = *(const u32x4*)(OB + base + 8);
    f32x4 o[4]; float ss = 0.f;
#pragma unroll
    for (int i = 0; i < 2; ++i) {
      o[i][0] = bflo(f0[2 * i]) + bflo(b0[2 * i]); o[i][1] = bfhi(f0[2 * i]) + bfhi(b0[2 * i]); o[i][2] = bflo(f0[2 * i + 1]) + bflo(b0[2 * i + 1]); o[i][3] = bfhi(f0[2 * i + 1]) + bfhi(b0[2 * i + 1]);
      o[2 + i][0] = bflo(f1[2 * i]) + bflo(b1[2 * i]); o[2 + i][1] = bfhi(f1[2 * i]) + bfhi(b1[2 * i]); o[2 + i][2] = bflo(f1[2 * i + 1]) + bflo(b1[2 * i + 1]); o[2 + i][3] = bfhi(f1[2 * i + 1]) + bfhi(b1[2 * i + 1]); }
#pragma unroll
    for (int i = 0; i < 4; ++i) ss += (o[i][0] * o[i][0] + o[i][1] * o[i][1]) + (o[i][2] * o[i][2] + o[i][3] * o[i][3]);
    ss += __shfl_xor(ss, 1); ss += __shfl_xor(ss, 2); ss += __shfl_xor(ss, 4);
    const float rstd = rsqrtf(ss * (1.f / 128.f) + 1e-6f);
    const u32x4 z0 = *(const u32x4*)(ZA + base), z1 = *(const u32x4*)(ZA + base + 8);
    float zf[16];
#pragma unroll
    for (int i = 0; i < 4; ++i) { zf[2 * i] = bflo(z0[i]); zf[2 * i + 1] = bfhi(z0[i]); zf[8 + 2 * i] = bflo(z1[i]); zf[8 + 2 * i + 1] = bfhi(z1[i]); }
    float y[16];
#pragma unroll
    for (int i = 0; i < 4; ++i) { const f32x4 g = *(const f32x4*)(gw_ + 4 * i);
#pragma unroll
      for (int e = 0; e < 4; ++e) y[4 * i + e] = o[i][e] * rstd * g[e] * zf[4 * i + e]; }
    u32x4 a, b2;
    a[0] = pk2(y[0], y[1]); a[1] = pk2(y[2], y[3]); a[2] = pk2(y[4], y[5]); a[3] = pk2(y[6], y[7]);
    b2[0] = pk2(y[8], y[9]); b2[1] = pk2(y[10], y[11]); b2[2] = pk2(y[12], y[13]); b2[3] = pk2(y[14], y[15]);
    *(u32x4*)(YA + (size_t)r * 1536 + lane * 16) = a; *(u32x4*)(YA + (size_t)r * 1536 + lane * 16 + 8) = b2;
  }
}

__device__ __forceinline__ void phase_final(const P& p, const int tid) {
  const int lane = tid & 63, gw = blockIdx.x * 8 + (tid >> 6), ngw = gridDim.x * 8;
  for (int r = gw; r < NTOK; r += ngw) {
    float* xr = p.out + (size_t)r * 1024;
    f32x4 v[4]; float ss = 0.f;
#pragma unroll
    for (int i = 0; i < 4; ++i) { v[i] = *(const f32x4*)(xr + 4 * (lane + 64 * i)); ss += (v[i][0] * v[i][0] + v[i][1] * v[i][1]) + (v[i][2] * v[i][2] + v[i][3] * v[i][3]); }
    const float rstd = rsqrtf(wave_sum(ss) * (1.f / 1024.f) + 1e-6f);
#pragma unroll
    for (int i = 0; i < 4; ++i) { const f32x4 fw = *(const f32x4*)(p.final_w + 4 * (lane + 64 * i)); *(f32x4*)(xr + 4 * (lane + 64 * i)) = v[i] * rstd * fw; }
  }
}

#define XB_TMO      128
#define XB_XCNT(j)  (256  + 64 * (j))
#define XB_XSUB(j)  (1280 + 64 * (j))
#define XB_XGEN(j)  (2304 + 64 * (j))
#define XB_TOP      3328
#define XB_TOPGEN   3392
#define XCD_BAR_WORDS 3456
#define XB_SPIN_CAP (1u << 18)
__device__ __forceinline__ unsigned xb_ld(unsigned* p)              { return __hip_atomic_load(p, __ATOMIC_RELAXED, __HIP_MEMORY_SCOPE_AGENT); }
__device__ __forceinline__ unsigned xb_add(unsigned* p, unsigned v) { return __hip_atomic_fetch_add(p, v, __ATOMIC_RELAXED, __HIP_MEMORY_SCOPE_AGENT); }
__device__ __forceinline__ unsigned xb_xcc_id() { return (unsigned)__builtin_amdgcn_s_getreg((3 << 11) | 20) & 0xFu; }
#define XB_SPIN(cond, bar) do { unsigned _sp = 0; while (cond) { __builtin_amdgcn_s_sleep(1); \
    if ((++_sp & 255u) == 0u) { if (xb_ld(&(bar)[XB_TMO])) break; if (_sp > XB_SPIN_CAP) { atomicAdd(&(bar)[XB_TMO], 1u); break; } } } } while (0)
__device__ __forceinline__ void xcd_barrier_complete(unsigned* bar, unsigned x, unsigned& nloc, unsigned& nx) {
    const unsigned G = gridDim.x * gridDim.y * gridDim.z;
    unsigned sum, cnt, mine, sp = 0u;
    for (;;) {
        sum = 0u; cnt = 0u; mine = 0u;
#pragma unroll
        for (unsigned j = 0; j < 16; ++j) { const unsigned c = xb_ld(&bar[XB_XCNT(j)]); sum += c; cnt += (c > 0u) ? 1u : 0u; mine = (j == x) ? c : mine; }
        if (sum == G) break;
        __builtin_amdgcn_s_sleep(1);
        if ((++sp & 255u) == 0u) { if (xb_ld(&bar[XB_TMO])) break; if (sp > XB_SPIN_CAP) { atomicAdd(&bar[XB_TMO], 1u); break; } }
    }
    nloc = mine > 0u ? mine : 1u; nx = cnt > 0u ? cnt : 1u;
}
__device__ __forceinline__ void xcd_barrier(unsigned* bar, volatile LAS unsigned* st, const int tid) {
    asm volatile("s_waitcnt vmcnt(0)" ::: "memory");
    __syncthreads();
    if (tid == 0) {
        const unsigned x = xb_xcc_id();
        __builtin_amdgcn_s_waitcnt(0);
        unsigned nloc = st[0], nx = st[1];
        if (nloc == 0u) { xcd_barrier_complete(bar, x, nloc, nx); st[0] = nloc; st[1] = nx; }
        const unsigned old = xb_add(&bar[XB_XSUB(x)], 1u);
        const unsigned gen = old / nloc;
        if (old + 1u == (gen + 1u) * nloc) {
            __builtin_amdgcn_fence(__ATOMIC_RELEASE, "agent");
            asm volatile("s_waitcnt vmcnt(0)" ::: "memory");
            const unsigned og = xb_add(&bar[XB_TOP], 1u);
            const unsigned tg = og / nx;
            if (og + 1u == (tg + 1u) * nx) xb_add(&bar[XB_TOPGEN], 1u);
            else XB_SPIN(xb_ld(&bar[XB_TOPGEN]) == tg, bar);
            __builtin_amdgcn_fence(__ATOMIC_ACQUIRE, "agent");
            xb_add(&bar[XB_XGEN(x)], 1u);
            asm volatile("s_waitcnt vmcnt(0)" ::: "memory");
        } else {
            XB_SPIN(xb_ld(&bar[XB_XGEN(x)]) == gen, bar);
            __builtin_amdgcn_fence(__ATOMIC_ACQUIRE, "agent");
            asm volatile("s_waitcnt vmcnt(0)" ::: "memory");
        }
    }
    __syncthreads();
}

struct EpiAll {
  int type, perm;
  unsigned char* ws; float* x; const float* f0; int rowbase, lshift; float scale; int pm0;
  __device__ __forceinline__ void operator()(const Acc& acc, const Unit& u0, int wr, int wc, int fr, int fq) const {
    asm volatile("" : "+v"(fr), "+v"(fq));
    Unit u = u0; u.pm += pm0;
    switch (type) {
      case 0: { EpiG1 E{ws, f0}; E(acc, u, wr, wc, fr, fq); break; }
      case 1: { EpiDFT E{ws, rowbase, lshift, scale}; E(acc, u, wr, wc, fr, fq); break; }
      case 2: { EpiG2 E{ws}; E(acc, u, wr, wc, fr, fq); break; }
      default: { EpiG3 E{x, f0}; E(acc, u, wr, wc, fr, fq); break; }
    }
  }
  __device__ __forceinline__ void hook(Acc& acc, const Unit& u0, int wr, int wc, int fr, int fq) const {
    asm volatile("" : "+v"(fr), "+v"(fq));
    Unit u = u0; u.pm += pm0;
    EpiG2 E{ws}; E.hook(acc, u, wr, wc, fr, fq);
  }
};

__global__ void __launch_bounds__(512, 2) fwd_megakernel(P p_arg) {
#if defined(__HIP_DEVICE_COMPILE__)
  extern __shared__ __attribute__((aligned(16))) unsigned char shm[];
  cg::grid_group grid = cg::this_grid();
  LAS unsigned char* lds = (LAS unsigned char*)shm;
  const int bid = blockIdx.x, G = gridDim.x;
  volatile LAS unsigned* xb_st = (volatile LAS unsigned*)(lds + 131072);
  if (threadIdx.x == 0) { xb_st[0] = 0u; xb_st[1] = 0u; }
  __syncthreads();
  for (int si = 0; si < 64; ++si) {
    const __attribute__((address_space(4))) P* pp = (const __attribute__((address_space(4))) P*)__builtin_amdgcn_kernarg_segment_ptr(); asm volatile("" : "+s"(pp));
    const unsigned code = pp->prog[si];
    if (code == 0xFFu) break;
    P p;
    p.x_prompt = pp->x_prompt; p.x_sample = pp->x_sample; p.state = pp->state; p.c = pp->c; p.c_ctx = pp->c_ctx; p.norm_w = pp->norm_w; p.w_ada = pp->w_ada; p.b_ada = pp->b_ada; p.w_in = pp->w_in;
    p.lb_raw = pp->lb_raw; p.gnorm_w = pp->gnorm_w; p.w_pa = pp->w_pa; p.w_pb = pp->w_pb; p.w_o = pp->w_o; p.final_w = pp->final_w; p.out = pp->out; p.ws = pp->ws;
    unsigned char* ws = p.ws;
    int tid = threadIdx.x; asm volatile("" : "+v"(tid));
    const int k = code & 15, l = (code >> 4) & 3;
    if (k == 8) { if (bid == 0) for (int i = tid; i < XCD_BAR_WORDS; i += 512) ((unsigned*)ws)[i] = 0u;
      p0_prologue(p, shm, tid); }
    else if (k == 9) { phase_final(p, tid); }
    else if (k == 0) phase_h(p, l, l == 0, tid);
    else if (k == 3) {
      int parity = 0;
      if (bid < 128) { for (int ci = 256 + bid * 2; ci < 256 + bid * 2 + 2; ++ci) scan_chain(p, l, ci >> 4, (ci >> 1) & 7, ci & 1, 0, 0, shm, parity, tid); }
      else {
        const int b2 = bid - 128;
        for (int ci = b2 * 2; ci < b2 * 2 + 2; ++ci) scan_chain(p, l, ci >> 4, (ci >> 1) & 7, ci & 1, 0, 0, shm, parity, tid);
        const int a0 = b2 < 64 ? b2 : 64 + (b2 - 64) * 2, an = b2 < 64 ? 1 : 2;
        for (int ai = a0; ai < a0 + an; ++ai) { const int ch = ai / 3, sg = ai - ch * 3; scan_chain(p, l, 32 + (ch >> 4), (ch >> 1) & 7, ch & 1, 1, sg, shm, parity, tid); }
      }
    }
    else if (k == 11) {
      int parity = 0; const int ch = bid >> 2, sg = bid & 3;
      scan_chain(p, l, 32 + (ch >> 4), (ch >> 1) & 7, ch & 1, 2, sg, shm, parity, tid);
    }
    else if (k == 4) phase_fin(p, l, tid);
    else if (k == 10) { }
    else if (k == 12) phase_fold(p, tid);
    else {
      Gemm g; StaticOrder S; EpiAll E; E.ws = ws; E.x = p.out; E.f0 = nullptr; E.rowbase = 0; E.lshift = 0; E.scale = 0.f; E.pm0 = 0;
      if (k == 1) { g = Gemm{(const u16*)(ws + WS_H), (const u16*)(ws + WS_WIN) + (size_t)l * NG1 * 1024, NTOK, NG1, 1024}; S.init(NTOK, NG1, G, bid);
        E.type = 0; E.perm = 1; E.f0 = (const float*)(ws + WS_LBS) + l * 2048; }
      else if (k == 2) {
        E.type = 1; E.perm = 1;
        if (bid < 128) { g = Gemm{(const u16*)(ws + WS_DFTS), (const u16*)(ws + WS_H), 4096, 2048, 4096}; S.init(4096, 2048, 128, bid);
          E.rowbase = NPROMPT; E.lshift = 12; E.scale = 0.001381067932f; }
        else { g = Gemm{(const u16*)(ws + WS_DFTP), (const u16*)(ws + WS_UT), 256, 16384, 512}; S.init(256, 16384, 64, bid < 192 ? bid - 128 : -1);
          E.rowbase = 0; E.lshift = 8; E.scale = 0.005524271728f; }
      }
      else {
        const bool isG2 = (k == 5) || (k == 6 && bid < 128);
        const int p0 = (k == 5) ? 0 : (k == 6 ? (bid < 128 ? 64 : 0) : 32), np = (k == 6) ? 32 : 64;
        const int gsz = (k == 6) ? 128 : G, gc = (k == 6 && bid >= 128) ? bid - 128 : bid;
        E.pm0 = p0; E.perm = 0;
        if (isG2) { g = Gemm{(const u16*)(ws + WS_YAB) + (size_t)p0 * 256 * 1536, (const u16*)(ws + WS_WPA) + (size_t)l * 1024 * 1536, np * 256, 1024, 1536}; E.type = 2; }
        else { g = Gemm{(const u16*)(ws + WS_MERGED) + (size_t)p0 * 256 * 1024, (const u16*)(ws + WS_WO) + (size_t)l * 1024 * 1024, np * 256, 1024, 1024}; E.type = 4; E.f0 = (const float*)(ws + WS_MOD) + (size_t)l * 5 * 3072; }
        S.init(np * 256, 1024, gsz, gc);
      }
      pg8::gemm_phase(lds, g, S, E, tid);
      __syncthreads();
    }
    if (code & 0x80u) {
      if (k == 8) { grid.sync(); if (tid == 0) (void)xb_add(&((unsigned*)ws)[XB_XCNT(xb_xcc_id())], 1u); }
      else xcd_barrier((unsigned*)ws, xb_st, tid);
    }
  }
#endif
}

extern "C" void kernel_launch(void* const* d_in, const int* in_sizes, int n_in, void* d_out, int out_size,
                              void* d_ws, size_t ws_size, hipStream_t stream) {
  static int grid_blocks = 0;
  if (!grid_blocks) {
    int dev = 0, cus = 0, per_cu = 0;
    if (n_in != 15 || ws_size < WS_END) { fprintf(stderr, "kernel_launch: unexpected inputs / workspace (%d, %zu)\n", n_in, ws_size); grid_blocks = -1; return; }
    (void)hipGetDevice(&dev);
    (void)hipDeviceGetAttribute(&cus, hipDeviceAttributeMultiprocessorCount, dev);
    (void)hipFuncSetAttribute((const void*)fwd_megakernel, hipFuncAttributeMaxDynamicSharedMemorySize, LDS_BYTES);
    (void)hipOccupancyMaxActiveBlocksPerMultiprocessor(&per_cu, (const void*)fwd_megakernel, 512, LDS_BYTES);
    if (per_cu < 1 || cus < 256) { fprintf(stderr, "kernel_launch: occupancy %d x %d CUs cannot hold the 256-workgroup grid\n", per_cu, cus); grid_blocks = -1; return; }
    grid_blocks = 256;
  }
  if (grid_blocks < 0) return;
  P p{};
  p.x_prompt = (const float*)d_in[0]; p.x_sample = (const float*)d_in[1]; p.state = (const float*)d_in[2]; p.c = (const float*)d_in[3]; p.c_ctx = (const float*)d_in[4];
  p.norm_w = (const float*)d_in[5]; p.w_ada = (const float*)d_in[6]; p.b_ada = (const float*)d_in[7]; p.w_in = (const float*)d_in[8]; p.lb_raw = (const float*)d_in[9];
  p.gnorm_w = (const float*)d_in[10]; p.w_pa = (const float*)d_in[11]; p.w_pb = (const float*)d_in[12]; p.w_o = (const float*)d_in[13]; p.final_w = (const float*)d_in[14];
  p.out = (float*)d_out; p.ws = (unsigned char*)d_ws;
  {
#ifndef REPMASK
#define REPMASK 0
#endif
    static const unsigned char nosync[13] = {0, 0, 1, 0, 0, 0, 0, 0, 0, 1, 0, 0, 0};
    int n = 0;
    auto emit = [&](int k, int l) { const int reps = ((REPMASK >> k) & 1) ? 2 : 1;
      for (int r = 0; r < reps; ++r) p.prog[n++] = (unsigned char)(k | (l << 4) | ((nosync[k] && r + 1 == reps) ? 0 : 0x80)); };
    emit(8, 0);
    for (int l = 0; l < DEPTH; ++l) for (int k = 0; k < 8; ++k) { if (k == 2) emit(12, l); emit(k, l); if (k == 3) emit(11, l); }
#ifdef NOPSYNCS
    for (int i = 0; i < NOPSYNCS; ++i) p.prog[n++] = (unsigned char)(10 | 0x80);
#endif
    emit(9, 0);
    while (n < 64) p.prog[n++] = 0xFF;
  }
  void* args[] = {&p};
  hipError_t e = hipLaunchCooperativeKernel((void*)fwd_megakernel, dim3(grid_blocks), dim3(512), args, LDS_BYTES, stream);
  if (e != hipSuccess) fprintf(stderr, "cooperative launch failed: %s\n", hipGetErrorString(e));
}
```

```cpp
#include <hip/hip_runtime.h>
#include <hip/hip_cooperative_groups.h>
#include <cstdio>
#include <cstdint>
namespace cg = cooperative_groups;

#define LAS __attribute__((address_space(3)))
typedef unsigned short u16;
typedef short bf16x8 __attribute__((ext_vector_type(8)));
typedef float f32x4 __attribute__((ext_vector_type(4)));
typedef unsigned u32x4 __attribute__((ext_vector_type(4)));
typedef unsigned u32x2 __attribute__((ext_vector_type(2)));

constexpr int DM = 1024, NTOK = 24576, NPROMPT = 8192, DEPTH = 4, NG1 = 8704, DIN = 8192;
constexpr int LDS_BYTES = 144 * 1024;
constexpr size_t MiB = 1u << 20;
constexpr size_t WS_MOD = 1 * MiB;
constexpr size_t WS_LBS = WS_MOD + 256 * 1024;
constexpr size_t WS_DFTP = 2 * MiB;
constexpr size_t WS_WIN = 4 * MiB;
constexpr size_t WS_WPA = 72 * MiB;
constexpr size_t WS_WPB = 80 * MiB;
constexpr size_t WS_WO = 84 * MiB;
constexpr size_t WS_DFTS = 92 * MiB;
constexpr size_t WS_H = 156 * MiB;
constexpr size_t WS_Q = 204 * MiB;
constexpr size_t WS_LF = 252 * MiB;
constexpr size_t WS_LB = 300 * MiB;
constexpr size_t WS_V = 348 * MiB;
constexpr size_t WS_ZA = 396 * MiB;
constexpr size_t WS_ZB = 444 * MiB;
constexpr size_t WS_GA = 468 * MiB;
constexpr size_t WS_GB = 516 * MiB;
constexpr size_t WS_UT = 564 * MiB;
constexpr size_t WS_YAB = 612 * MiB;
constexpr size_t WS_OF = 684 * MiB;
constexpr size_t WS_OB = 780 * MiB;
constexpr size_t WS_SLOC = 876 * MiB;
constexpr size_t WS_LSEG = 1 * MiB + 512 * 1024;
constexpr size_t WS_END = 889 * MiB;
constexpr size_t WS_MERGED = WS_OB;
constexpr size_t UT_SAMPLE_OFF = (size_t)32 * 512 * 512;

struct P {
  const float *x_prompt, *x_sample, *state, *c, *c_ctx, *norm_w, *w_ada, *b_ada, *w_in, *lb_raw, *gnorm_w, *w_pa, *w_pb, *w_o, *final_w;
  float* out; unsigned char* ws;
  unsigned char prog[64];
};

typedef float f32x2v __attribute__((ext_vector_type(2)));
typedef __bf16 bf16x2v __attribute__((ext_vector_type(2)));
__device__ __forceinline__ unsigned pk2(float lo, float hi) { const f32x2v v = {lo, hi}; const bf16x2v b = __builtin_convertvector(v, bf16x2v); return __builtin_bit_cast(unsigned, b); }
__device__ __forceinline__ u16 f2bf(float f) { unsigned u = __float_as_uint(f); u += 0x7FFFu + ((u >> 16) & 1u); return (u16)(u >> 16); }
__device__ __forceinline__ float bf2f(unsigned b) { return __uint_as_float(b << 16); }
__device__ __forceinline__ float bflo(unsigned w) { return __uint_as_float(w << 16); }
__device__ __forceinline__ float bfhi(unsigned w) { return __uint_as_float(w & 0xFFFF0000u); }
__device__ __forceinline__ float h2f(unsigned short h) { return (float)__builtin_bit_cast(_Float16, h); }
__device__ __forceinline__ unsigned short f2h(float f) { return __builtin_bit_cast(unsigned short, (_Float16)f); }
__device__ __forceinline__ float siluf(float x) { return x * __builtin_amdgcn_rcpf(1.f + __expf(-x)); }
__device__ __forceinline__ float sigmf(float x) { return __builtin_amdgcn_rcpf(1.f + __expf(-x)); }
__device__ __forceinline__ float wave_sum(float v) {
#pragma unroll
  for (int o = 1; o < 64; o <<= 1) v += __shfl_xor(v, o);
  return v;
}

namespace pg8 {
constexpr int BM = 256, BK = 64, HALF = 128, HTB = HALF * BK * 2, STAGE_BYTES = 8 * HTB, NXCD = 8, WGM = 4;
__host__ __device__ __forceinline__ int lds_byte(int r, int c) { const int st = (r >> 4) * 2 + (c >> 5), rr = r & 15, cc = c & 31, ob = rr * 64 + cc * 2; return st * 1024 + (ob ^ (((ob >> 9) & 1) << 5)); }
__host__ __device__ __forceinline__ void stage_rc(int b, int& R, int& C) { const int st = b / 1024, sb = b % 1024, swz = sb ^ (((sb >> 9) & 1) << 5); R = (st >> 1) * 16 + swz / 64; C = (st & 1) * 32 + (swz % 64) / 2; }
__host__ __device__ __forceinline__ int perm32(int rho) { const int n = rho >> 4, i = rho & 15; return 8 * (i >> 2) + 4 * n + (i & 3); }
struct Unit { int pm, pn; };
struct Gemm { const u16* A; const u16* Bt; int M, N, K; };
struct StaticOrder {
  int nM, nN, nwg, G, c;
  __device__ void init(int M, int N, int G_, int c_) { nM = M / BM; nN = N / BM; nwg = nM * nN; G = G_; c = c_; }
  __device__ bool next(int i, Unit& u) const {
    const long L = (long)i * G + c; if (c < 0 || L >= nwg) return false;
    int wgid = (int)L; { const int q = nwg / NXCD, r = nwg % NXCD, xcd = wgid % NXCD, off = wgid / NXCD; wgid = (xcd < r ? xcd * (q + 1) : r * (q + 1) + (xcd - r) * q) + off; }
    const int nig = WGM * nN, gid = wgid / nig, fm = gid * WGM, gsz = (nM - fm) < WGM ? (nM - fm) : WGM;
    u.pm = fm + ((wgid % nig) % gsz); u.pn = (wgid % nig) / gsz; return true;
  }
};
template <class Epi>
__device__ __forceinline__ void gemm_phase(LAS unsigned char* lds, const Gemm g, const StaticOrder& S, const Epi& E, const int tid) {
  const int wid = __builtin_amdgcn_readfirstlane(tid >> 6), lane = tid & 63, wr = wid >> 2, wc = wid & 3, fr = lane & 15, fq = lane >> 4;
  const int K = g.K, nt = K / BK;
  unsigned voffA[2], voffB[2];
#pragma unroll
  for (int i = 0; i < 2; ++i) { int R, C; stage_rc(tid * 16 + i * 8192, R, C); const int Rb = E.perm ? ((R & ~31) + perm32(R & 31)) : R;
    voffA[i] = (unsigned)(R * K + C) * 2u; voffB[i] = (unsigned)(Rb * K + C) * 2u; }
  const size_t kstep = (size_t)(BK * 2);
  const size_t hstep = (size_t)HALF * K * 2;
  const size_t tstep = 2 * hstep;
  const unsigned ldsw = (unsigned)wid * 1024u;
  const int aoff = lds_byte(wr * 64 + fr, fq * 8), boff = lds_byte(wc * 32 + fr, fq * 8);
#define PG8_SA(b, h) (((b) * 2 + (h)) * HTB)
#define PG8_SB(b, h) ((4 + (b) * 2 + (h)) * HTB)
#define PG8_STAGE(bufoff, gbase, voff) do { _Pragma("unroll") for (int _i = 0; _i < 2; ++_i) \
    __builtin_amdgcn_global_load_lds((const unsigned*)((const char*)(gbase) + (voff)[_i]), (LAS unsigned*)(lds + (bufoff) + ldsw + _i * 8192), 16, 0, 0); } while (0)
#define PG8_LDA(dst, b, h) do { _Pragma("unroll") for (int m = 0; m < 4; ++m) _Pragma("unroll") for (int k = 0; k < 2; ++k) dst[m][k] = *(const LAS bf16x8*)(lds + PG8_SA(b, h) + aoff + m * 2048 + k * 1024); } while (0)
#define PG8_LDB(dst, b, h) do { _Pragma("unroll") for (int n = 0; n < 2; ++n) _Pragma("unroll") for (int k = 0; k < 2; ++k) dst[n][k] = *(const LAS bf16x8*)(lds + PG8_SB(b, h) + boff + n * 2048 + k * 1024); } while (0)
#define PG8_MMA(ai, bj, At, Bt) do { __builtin_amdgcn_s_setprio(1); _Pragma("unroll") for (int m = 0; m < 4; ++m) _Pragma("unroll") for (int n = 0; n < 2; ++n) _Pragma("unroll") for (int k = 0; k < 2; ++k) \
    acc[ai][bj][m][n] = __builtin_amdgcn_mfma_f32_16x16x32_bf16(Bt[n][k], At[m][k], acc[ai][bj][m][n], 0, 0, 0); __builtin_amdgcn_s_setprio(0); } while (0)
#define PG8_WAIT_V(n) asm volatile("s_waitcnt vmcnt(" #n ")" ::: "memory")
#define PG8_WAIT_L(n) asm volatile("s_waitcnt lgkmcnt(" #n ")" ::: "memory")
#define PG8_BAR __builtin_amdgcn_s_barrier()
#define PG8_SCHED __builtin_amdgcn_sched_barrier(0)
  Unit cur, nxt; int ui = 0;
  if (!S.next(0, cur)) return;
  f32x4 acc[2][2][4][2];
#pragma unroll
  for (int a = 0; a < 2; ++a)
#pragma unroll
    for (int b = 0; b < 2; ++b)
#pragma unroll
      for (int m = 0; m < 4; ++m)
#pragma unroll
        for (int n = 0; n < 2; ++n) acc[a][b][m][n] = (f32x4){0.f, 0.f, 0.f, 0.f};
  bf16x8 At[4][2], B0[2][2], B1[2][2];
  const char* cA = (const char*)g.A + (size_t)cur.pm * tstep; const char* cB = (const char*)g.Bt + (size_t)cur.pn * tstep;
  PG8_STAGE(PG8_SB(0, 0), cB, voffB); PG8_STAGE(PG8_SA(0, 0), cA, voffA); PG8_STAGE(PG8_SB(0, 1), cB + hstep, voffB); PG8_STAGE(PG8_SA(0, 1), cA + hstep, voffA);
  if (wr == 1) PG8_BAR;
  PG8_WAIT_V(4); PG8_BAR;
  PG8_STAGE(PG8_SB(1, 0), cB + kstep, voffB); PG8_STAGE(PG8_SA(1, 0), cA + kstep, voffA); PG8_STAGE(PG8_SB(1, 1), cB + hstep + kstep, voffB);
  PG8_WAIT_V(6); PG8_BAR;
  for (;;) {
    const bool has_next = S.next(ui + 1, nxt);
    const char* nA = has_next ? (const char*)g.A + (size_t)nxt.pm * tstep : cA; const char* nB = has_next ? (const char*)g.Bt + (size_t)nxt.pn * tstep : cB;
    for (int t = 0; t < nt; t += 2) {
      const bool last = (t == nt - 2);
      if (E.type == 2 && t == 16) E.hook(acc, cur, wr, wc, fr, fq);
      const char* a1 = cA + (size_t)(t + 1) * kstep;
      const char* a2 = last ? nA : cA + (size_t)(t + 2) * kstep; const char* b2 = last ? nB : cB + (size_t)(t + 2) * kstep;
      const char* a3 = a2 + kstep; const char* b3 = b2 + kstep;
      PG8_LDB(B0, 0, 0); PG8_SCHED; PG8_LDA(At, 0, 0); PG8_STAGE(PG8_SA(1, 1), a1 + hstep, voffA);
      PG8_WAIT_L(8); PG8_BAR; PG8_WAIT_L(0); PG8_MMA(0, 0, At, B0); PG8_BAR; PG8_SCHED;
      PG8_LDB(B1, 0, 1); PG8_STAGE(PG8_SB(0, 0), b2, voffB);
      PG8_BAR; PG8_WAIT_L(0); PG8_MMA(0, 1, At, B1); PG8_BAR;
      PG8_LDA(At, 0, 1); PG8_STAGE(PG8_SA(0, 0), a2, voffA);
      PG8_BAR; PG8_WAIT_L(0); PG8_MMA(1, 0, At, B0); PG8_BAR; PG8_SCHED;
      PG8_STAGE(PG8_SB(0, 1), b2 + hstep, voffB);
      PG8_WAIT_V(6); PG8_BAR; PG8_MMA(1, 1, At, B1); PG8_BAR;
      PG8_LDB(B0, 1, 0); PG8_SCHED; PG8_LDA(At, 1, 0); PG8_STAGE(PG8_SA(0, 1), a2 + hstep, voffA);
      PG8_WAIT_L(8); PG8_BAR; PG8_WAIT_L(0); PG8_MMA(0, 0, At, B0); PG8_BAR; PG8_SCHED;
      PG8_LDB(B1, 1, 1); PG8_STAGE(PG8_SB(1, 0), b3, voffB);
      PG8_BAR; PG8_WAIT_L(0); PG8_MMA(0, 1, At, B1); PG8_BAR;
      PG8_LDA(At, 1, 1); PG8_STAGE(PG8_SA(1, 0), a3, voffA);
      PG8_BAR; PG8_WAIT_L(0); PG8_MMA(1, 0, At, B0); PG8_BAR; PG8_SCHED;
      PG8_STAGE(PG8_SB(1, 1), b3 + hstep, voffB);
      PG8_WAIT_V(6); PG8_BAR; PG8_MMA(1, 1, At, B1); PG8_BAR;
    }
    E(acc, cur, wr, wc, fr, fq);
    if (!has_next) break;
#pragma unroll
    for (int a = 0; a < 2; ++a)
#pragma unroll
      for (int b = 0; b < 2; ++b)
#pragma unroll
        for (int m = 0; m < 4; ++m)
#pragma unroll
          for (int n = 0; n < 2; ++n) acc[a][b][m][n] = (f32x4){0.f, 0.f, 0.f, 0.f};
    cur = nxt; cA = nA; cB = nB; ++ui;
  }
  PG8_WAIT_V(0);
  if (wr == 0) PG8_BAR;
  PG8_BAR;
#undef PG8_SA
#undef PG8_SB
#undef PG8_STAGE
#undef PG8_LDA
#undef PG8_LDB
#undef PG8_MMA
#undef PG8_WAIT_V
#undef PG8_WAIT_L
#undef PG8_BAR
#undef PG8_SCHED
}
}
using pg8::Unit; using pg8::Gemm; using pg8::StaticOrder;
typedef f32x4 Acc[2][2][4][2];

struct EpiG1 {
  static constexpr bool PERM = true;
  unsigned char* ws; const float* lbs;
  __device__ __forceinline__ void operator()(const Acc& acc, const Unit& u, int wr, int wc, int fr, int fq) const {
    const int pn = u.pn, row0 = u.pm * 256 + wr * 64 + fr;
    if (pn >= 20 && pn < 24) {
      u16* UT = (u16*)(ws + WS_UT);
      const int part = (pn - 20) >> 1;
#pragma unroll
      for (int ai = 0; ai < 2; ++ai)
#pragma unroll
        for (int m = 0; m < 4; ++m) {
          const int r = row0 + ai * 128 + m * 16;
          size_t base; size_t chs;
          if (r < NPROMPT) { const int bp = r >> 8, l = r & 255; base = (size_t)bp * 512 * 512 + part * 256 + l; chs = 512; }
          else { const int rr = r - NPROMPT, b = rr >> 12, l = rr & 4095; base = UT_SAMPLE_OFF + (size_t)b * 512 * 8192 + part * 4096 + l; chs = 8192; }
#pragma unroll
          for (int bj = 0; bj < 2; ++bj) {
            const int ch0 = ((pn - 20) & 1) * 256 + bj * 128 + wc * 32 + 8 * fq;
#pragma unroll
            for (int n = 0; n < 2; ++n)
#pragma unroll
              for (int e = 0; e < 4; e += 2) { const unsigned pr = pk2(acc[ai][bj][m][n][e], acc[ai][bj][m][n][e + 1]);
                UT[base + (size_t)(ch0 + 4 * n + e) * chs] = (u16)(pr & 0xFFFFu); UT[base + (size_t)(ch0 + 4 * n + e + 1) * chs] = (u16)(pr >> 16); }
          }
        }
      return;
    }
    int act, ld = 1024, colt; size_t off;
    if (pn < 4) { act = 1; off = WS_Q; colt = pn * 256; }
    else if (pn < 8) { act = 3; off = WS_LF; colt = (pn - 4) * 256; }
    else if (pn < 12) { act = 4; off = WS_LB; colt = (pn - 8) * 256; }
    else if (pn < 16) { act = 0; off = WS_V; colt = (pn - 12) * 256; }
    else if (pn < 20) { act = 1; off = WS_ZA; colt = (pn - 16) * 256; }
    else if (pn < 26) { act = 1; off = WS_ZB; colt = (pn - 24) * 256; ld = 512; }
    else if (pn < 30) { act = 2; off = WS_GA; colt = (pn - 26) * 256; }
    else { act = 2; off = WS_GB; colt = (pn - 30) * 256; }
    u16* dst = (u16*)(ws + off);
    const int col0 = colt + wc * 32 + 8 * fq;
    f32x4 lbv[2][2];
    if (act >= 3) { const float* lb = lbs + (act == 4 ? 1024 : 0) + col0;
#pragma unroll
      for (int bj = 0; bj < 2; ++bj) { lbv[bj][0] = *(const f32x4*)(lb + bj * 128); lbv[bj][1] = *(const f32x4*)(lb + bj * 128 + 4); } }
#pragma unroll
    for (int ai = 0; ai < 2; ++ai)
#pragma unroll
      for (int m = 0; m < 4; ++m) {
        u16* rowp = dst + (size_t)(row0 + ai * 128 + m * 16) * ld + col0;
#pragma unroll
        for (int bj = 0; bj < 2; ++bj) {
          float v[8];
#pragma unroll
          for (int e = 0; e < 8; ++e) v[e] = acc[ai][bj][m][e >> 2][e & 3];
          u32x4 o;
          if (act >= 3) {
            unsigned short hv[8];
#pragma unroll
            for (int e = 0; e < 8; ++e) { const float oml = 1.f - lbv[bj][e >> 2][e & 3]; const float kk = oml * __builtin_amdgcn_rcpf(1.f + __expf(v[e])); hv[e] = f2h(fmaxf(__log2f(1.f - kk), -57.f)); }
            o[0] = hv[0] | ((unsigned)hv[1] << 16); o[1] = hv[2] | ((unsigned)hv[3] << 16); o[2] = hv[4] | ((unsigned)hv[5] << 16); o[3] = hv[6] | ((unsigned)hv[7] << 16);
          } else {
            if (act == 1) {
#pragma unroll
              for (int e = 0; e < 8; ++e) v[e] = siluf(v[e]);
            } else if (act == 2) {
#pragma unroll
              for (int e = 0; e < 8; ++e) v[e] = sigmf(v[e]);
            }
            o[0] = pk2(v[0], v[1]); o[1] = pk2(v[2], v[3]); o[2] = pk2(v[4], v[5]); o[3] = pk2(v[6], v[7]);
          }
          *(u32x4*)(rowp + bj * 128) = o;
        }
      }
  }
};
struct EpiDFT {
  static constexpr bool PERM = true;
  unsigned char* ws; int rowbase, lshift; float scale;
  __device__ __forceinline__ void operator()(const Acc& acc, const Unit& u, int wr, int wc, int fr, int fq) const {
    const u16* ZB = (const u16*)(ws + WS_ZB); u16* YB = (u16*)(ws + WS_YAB);
    const int k0 = u.pm * 256 + wr * 64 + fr;
    const int n0 = u.pn * 256 + wc * 32 + 8 * fq, b = n0 >> 9, ch0 = n0 & 511;
    const size_t R0 = (size_t)rowbase + ((size_t)b << lshift) + k0;
    const u16* zb = ZB + R0 * 512 + ch0; u16* yb = YB + R0 * 1536 + 1024 + ch0;
#pragma unroll
    for (int ai = 0; ai < 2; ++ai) {
      u32x4 z[4][2];
#pragma unroll
      for (int m = 0; m < 4; ++m)
#pragma unroll
        for (int bj = 0; bj < 2; ++bj) z[m][bj] = *(const u32x4*)(zb + (ai * 128 + m * 16) * 512 + bj * 128);
#pragma unroll
      for (int m = 0; m < 4; ++m)
#pragma unroll
        for (int bj = 0; bj < 2; ++bj) {
          const u32x4 zz = z[m][bj]; u32x4 o;
          o[0] = pk2(acc[ai][bj][m][0][0] * scale * bflo(zz[0]), acc[ai][bj][m][0][1] * scale * bfhi(zz[0]));
          o[1] = pk2(acc[ai][bj][m][0][2] * scale * bflo(zz[1]), acc[ai][bj][m][0][3] * scale * bfhi(zz[1]));
          o[2] = pk2(acc[ai][bj][m][1][0] * scale * bflo(zz[2]), acc[ai][bj][m][1][1] * scale * bfhi(zz[2]));
          o[3] = pk2(acc[ai][bj][m][1][2] * scale * bflo(zz[3]), acc[ai][bj][m][1][3] * scale * bfhi(zz[3]));
          *(u32x4*)(yb + (ai * 128 + m * 16) * 1536 + bj * 128) = o;
        }
      __builtin_amdgcn_sched_barrier(0);
    }
  }
};
struct EpiG2 {
  static constexpr bool PERM = false;
  unsigned char* ws;
  __device__ __forceinline__ void hook(Acc& acc, const Unit& u, int wr, int wc, int fr, int fq) const {
    const u16* GA = (const u16*)(ws + WS_GA); const u16* GB = (const u16*)(ws + WS_GB);
    const int row0 = u.pm * 256 + wr * 64 + fr, col0 = u.pn * 256 + wc * 32 + 4 * fq;
#pragma unroll
    for (int ai = 0; ai < 2; ++ai) {
      u32x2 ga[4][2][2], gb[4][2][2];
#pragma unroll
      for (int m = 0; m < 4; ++m)
#pragma unroll
        for (int bj = 0; bj < 2; ++bj)
#pragma unroll
          for (int n = 0; n < 2; ++n) { const size_t idx = (size_t)(row0 + ai * 128 + m * 16) * 1024 + col0 + bj * 128 + n * 16;
            ga[m][bj][n] = *(const u32x2*)(GA + idx); gb[m][bj][n] = *(const u32x2*)(GB + idx); }
#pragma unroll
      for (int m = 0; m < 4; ++m)
#pragma unroll
        for (int bj = 0; bj < 2; ++bj)
#pragma unroll
          for (int n = 0; n < 2; ++n) { const u32x2 a = ga[m][bj][n], b = gb[m][bj][n]; f32x4& v = acc[ai][bj][m][n];
            v[0] *= bflo(a[0]) * __builtin_amdgcn_rcpf(fmaxf(bflo(b[0]), 1e-30f)); v[1] *= bfhi(a[0]) * __builtin_amdgcn_rcpf(fmaxf(bfhi(b[0]), 1e-30f));
            v[2] *= bflo(a[1]) * __builtin_amdgcn_rcpf(fmaxf(bflo(b[1]), 1e-30f)); v[3] *= bfhi(a[1]) * __builtin_amdgcn_rcpf(fmaxf(bfhi(b[1]), 1e-30f)); }
      __builtin_amdgcn_sched_barrier(0);
    }
  }
  __device__ __forceinline__ void operator()(const Acc& acc, const Unit& u, int wr, int wc, int fr, int fq) const {
    const u16* GB = (const u16*)(ws + WS_GB); u16* MG = (u16*)(ws + WS_MERGED);
    const int row0 = u.pm * 256 + wr * 64 + fr, col0 = u.pn * 256 + wc * 32 + 4 * fq;
#pragma unroll
    for (int ai = 0; ai < 2; ++ai) {
      u32x2 gb[4][2][2];
#pragma unroll
      for (int m = 0; m < 4; ++m)
#pragma unroll
        for (int bj = 0; bj < 2; ++bj)
#pragma unroll
          for (int n = 0; n < 2; ++n) gb[m][bj][n] = *(const u32x2*)(GB + (size_t)(row0 + ai * 128 + m * 16) * 1024 + col0 + bj * 128 + n * 16);
#pragma unroll
      for (int m = 0; m < 4; ++m)
#pragma unroll
        for (int bj = 0; bj < 2; ++bj)
#pragma unroll
          for (int n = 0; n < 2; ++n) { const u32x2 b = gb[m][bj][n]; const f32x4 v = acc[ai][bj][m][n];
            u32x2 o; o[0] = pk2(v[0] * bflo(b[0]), v[1] * bfhi(b[0])); o[1] = pk2(v[2] * bflo(b[1]), v[3] * bfhi(b[1]));
            *(u32x2*)(MG + (size_t)(row0 + ai * 128 + m * 16) * 1024 + col0 + bj * 128 + n * 16) = o; }
      __builtin_amdgcn_sched_barrier(0);
    }
  }
};
struct EpiG3 {
  static constexpr bool PERM = false;
  float* x; const float* modl;
  __device__ __forceinline__ void operator()(const Acc& acc, const Unit& u, int wr, int wc, int fr, int fq) const {
    const int j = u.pm < 32 ? 0 : 1 + ((u.pm - 32) >> 4);
    const float* gt = modl + j * 3072 + 2048;
    const int row0 = u.pm * 256 + wr * 64 + fr, col0 = u.pn * 256 + wc * 32 + 4 * fq;
    f32x4 gv[2][2];
#pragma unroll
    for (int bj = 0; bj < 2; ++bj)
#pragma unroll
      for (int n = 0; n < 2; ++n) gv[bj][n] = *(const f32x4*)(gt + col0 + bj * 128 + n * 16);
#pragma unroll
    for (int ai = 0; ai < 2; ++ai)
#pragma unroll
      for (int mp = 0; mp < 2; ++mp) {
        f32x4 xv[2][2][2];
#pragma unroll
        for (int mi = 0; mi < 2; ++mi)
#pragma unroll
          for (int bj = 0; bj < 2; ++bj)
#pragma unroll
            for (int n = 0; n < 2; ++n) xv[mi][bj][n] = *(const f32x4*)(x + (size_t)(row0 + ai * 128 + (2 * mp + mi) * 16) * 1024 + col0 + bj * 128 + n * 16);
#pragma unroll
        for (int mi = 0; mi < 2; ++mi)
#pragma unroll
          for (int bj = 0; bj < 2; ++bj)
#pragma unroll
            for (int n = 0; n < 2; ++n) *(f32x4*)(x + (size_t)(row0 + ai * 128 + (2 * mp + mi) * 16) * 1024 + col0 + bj * 128 + n * 16) = xv[mi][bj][n] + gv[bj][n] * acc[ai][bj][2 * mp + mi][n];
        __builtin_amdgcn_sched_barrier(0);
      }
  }
};

__device__ __forceinline__ void p0_prologue(const P& p, unsigned char* shm, const int tid) {
  const int bid = blockIdx.x, G = gridDim.x;
  float* fs = (float*)shm;
  for (int i = bid * 512 + tid; i < 2048; i += G * 512) {
    float r[4], mx = -1e30f;
    for (int l = 0; l < 4; ++l) { r[l] = p.lb_raw[l * 2048 + i]; mx = fmaxf(mx, r[l]); }
    float s = 0.f; for (int l = 0; l < 4; ++l) { r[l] = expf(r[l] - mx); s += r[l]; }
    float cs = 0.f; float* lbs = (float*)(p.ws + WS_LBS);
    for (int l = 0; l < 4; ++l) { if (l > 0) cs += r[l] / s; lbs[l * 2048 + i] = cs; }
  }
  for (int it = bid; it < 96; it += G) {
    const int l = it / 24, n0 = (it % 24) * 128;
    for (int i = tid; i < 5120; i += 512) { const int j = i >> 10, k = i & 1023; const float cv = j == 0 ? p.c_ctx[k] : p.c[(j - 1) * 1024 + k]; fs[i] = cv / (1.f + expf(-cv)); }
    __syncthreads();
    const int col = tid & 127, kq = tid >> 7;
    float a[5] = {0.f, 0.f, 0.f, 0.f, 0.f};
    const float* w = p.w_ada + ((size_t)l * 1024 + kq * 256) * 3072 + n0 + col;
    for (int k = 0; k < 256; k += 32) {
      float wv[32];
#pragma unroll
      for (int u = 0; u < 32; ++u) wv[u] = w[(size_t)(k + u) * 3072];
#pragma unroll
      for (int u = 0; u < 32; ++u)
#pragma unroll
        for (int j = 0; j < 5; ++j) a[j] += fs[j * 1024 + kq * 256 + k + u] * wv[u];
    }
    __syncthreads();
#pragma unroll
    for (int j = 0; j < 5; ++j) fs[5120 + (kq * 5 + j) * 128 + col] = a[j];
    __syncthreads();
    if (tid < 128) {
      float* modv = (float*)(p.ws + WS_MOD);
#pragma unroll
      for (int j = 0; j < 5; ++j) { const float s = fs[5120 + (0 * 5 + j) * 128 + tid] + fs[5120 + (1 * 5 + j) * 128 + tid] + fs[5120 + (2 * 5 + j) * 128 + tid] + fs[5120 + (3 * 5 + j) * 128 + tid];
        modv[((size_t)l * 5 + j) * 3072 + n0 + tid] = s + p.b_ada[l * 3072 + n0 + tid]; }
    }
    __syncthreads();
  }
  for (int it = bid; it < 256; it += G) {
    const int l = it >> 6, g = (it >> 4) & 3, k0 = (it & 15) * 64;
    for (int i = tid; i < 64 * 32; i += 512) { const int kk = i >> 5, c4 = (i & 31) * 4;
      const f32x4 v = *(const f32x4*)(p.w_in + ((size_t)l * 1024 + k0 + kk) * DIN + 5120 + g * 128 + c4);
      fs[(c4 + 0) * 68 + kk] = v[0]; fs[(c4 + 1) * 68 + kk] = v[1]; fs[(c4 + 2) * 68 + kk] = v[2]; fs[(c4 + 3) * 68 + kk] = v[3]; }
    __syncthreads();
    const int m = tid & 127, kq = tid >> 7;
    float sm, cm; sincospif((float)m / 64.f, &sm, &cm);
    float cr = 1.f, sr = 0.f, ac[16], as[16];
#pragma unroll
    for (int i = 0; i < 16; ++i) { ac[i] = 0.f; as[i] = 0.f; }
    for (int c = 0; c < 128; ++c) {
      const float* wrow = fs + c * 68 + kq * 16;
#pragma unroll
      for (int i4 = 0; i4 < 4; ++i4) { const f32x4 wv = *(const f32x4*)(wrow + i4 * 4);
#pragma unroll
        for (int e = 0; e < 4; ++e) { ac[i4 * 4 + e] += wv[e] * cr; as[i4 * 4 + e] -= wv[e] * sr; } }
      const float c2 = cr * cm - sr * sm, s2 = sr * cm + cr * sm; cr = c2; sr = s2;
    }
    u16* WIN = (u16*)(p.ws + WS_WIN) + (size_t)l * NG1 * 1024;
    u32x4 o0, o1, o2, o3;
    o0[0] = pk2(ac[0], ac[1]); o0[1] = pk2(ac[2], ac[3]); o0[2] = pk2(ac[4], ac[5]); o0[3] = pk2(ac[6], ac[7]);
    o1[0] = pk2(ac[8], ac[9]); o1[1] = pk2(ac[10], ac[11]); o1[2] = pk2(ac[12], ac[13]); o1[3] = pk2(ac[14], ac[15]);
    o2[0] = pk2(as[0], as[1]); o2[1] = pk2(as[2], as[3]); o2[2] = pk2(as[4], as[5]); o2[3] = pk2(as[6], as[7]);
    o3[0] = pk2(as[8], as[9]); o3[1] = pk2(as[10], as[11]); o3[2] = pk2(as[12], as[13]); o3[3] = pk2(as[14], as[15]);
    u16* dc = WIN + (size_t)(5120 + g * 128 + m) * 1024 + k0 + kq * 16;
    u16* ds = WIN + (size_t)(5120 + 512 + g * 128 + m) * 1024 + k0 + kq * 16;
    *(u32x4*)dc = o0; *(u32x4*)(dc + 8) = o1; *(u32x4*)ds = o2; *(u32x4*)(ds + 8) = o3;
    __syncthreads();
  }
  {
    constexpr int I_IN = 16 * 120, I_PA = 16 * 16, I_PB = 8 * 16, I_O = 16 * 16, I_L = I_IN + I_PA + I_PB + I_O;
    for (int it0 = bid; it0 < 4 * I_L; it0 += 4 * G) {
#pragma unroll
      for (int q = 0; q < 4; ++q) {
        const int it = it0 + q * G; if (it >= 4 * I_L) break;
        const int l = it / I_L; int r = it % I_L;
        const float* W; int Nsrc, kb, nsrc0;
        if (r < I_IN) { kb = r / 120; const int nb = r % 120; nsrc0 = nb * 64 + (nb * 64 >= 5120 ? 512 : 0); W = p.w_in + (size_t)l * 1024 * DIN; Nsrc = DIN; }
        else if ((r -= I_IN) < I_PA) { kb = r / 16; nsrc0 = (r % 16) * 64; W = p.w_pa + (size_t)l * 1024 * 1024; Nsrc = 1024; }
        else if ((r -= I_PA) < I_PB) { kb = r / 16; nsrc0 = (r % 16) * 64; W = p.w_pb + (size_t)l * 512 * 1024; Nsrc = 1024; }
        else { r -= I_PB; kb = r / 16; nsrc0 = (r % 16) * 64; W = p.w_o + (size_t)l * 1024 * 1024; Nsrc = 1024; }
        const int k0 = kb * 64;
#pragma unroll
        for (int ps = 0; ps < 8; ++ps) { const int kk = ps * 8 + (tid >> 6), nn = tid & 63; fs[q * 4160 + kk * 65 + nn] = W[(size_t)(k0 + kk) * Nsrc + nsrc0 + nn]; }
      }
      __syncthreads();
#pragma unroll
      for (int q = 0; q < 4; ++q) {
        const int it = it0 + q * G; if (it >= 4 * I_L) break;
        const int l = it / I_L; int r = it % I_L;
        u16* WT; int Kd, kb, ndst0;
        if (r < I_IN) { kb = r / 120; const int nb = r % 120; ndst0 = nb * 64; if (ndst0 >= 5120) ndst0 += 1024; WT = (u16*)(p.ws + WS_WIN) + (size_t)l * NG1 * 1024; Kd = 1024; }
        else if ((r -= I_IN) < I_PA) { kb = r / 16; ndst0 = (r % 16) * 64; WT = (u16*)(p.ws + WS_WPA) + (size_t)l * 1024 * 1536; Kd = 1536; }
        else if ((r -= I_PA) < I_PB) { kb = r / 16; ndst0 = (r % 16) * 64; WT = (u16*)(p.ws + WS_WPA) + (size_t)l * 1024 * 1536 + 1024; Kd = 1536; }
        else { r -= I_PB; kb = r / 16; ndst0 = (r % 16) * 64; WT = (u16*)(p.ws + WS_WO) + (size_t)l * 1024 * 1024; Kd = 1024; }
        const int k0 = kb * 64;
        const int nn = tid >> 3, kc = tid & 7; const float* sp = fs + q * 4160 + (8 * kc) * 65 + nn;
        u32x4 o; o[0] = pk2(sp[0], sp[65]); o[1] = pk2(sp[2 * 65], sp[3 * 65]); o[2] = pk2(sp[4 * 65], sp[5 * 65]); o[3] = pk2(sp[6 * 65], sp[7 * 65]);
        *(u32x4*)(WT + (size_t)(ndst0 + nn) * Kd + k0 + 8 * kc) = o;
      }
      __syncthreads();
    }
  }
  {
    __syncthreads();
    for (int r = tid; r < 4096; r += 512) { float sv, cv; sincospif((float)r * (1.f / 2048.f), &sv, &cv); fs[r] = cv; fs[4096 + r] = sv; }
    __syncthreads();
    u16* DS = (u16*)(p.ws + WS_DFTS);
    for (size_t i = (size_t)bid * 512 + tid; i < (size_t)4096 * 512; i += (size_t)G * 512) {
      const int k = (int)(i >> 9), j0 = (int)(i & 511) * 8; const int part = j0 >> 11, jj = j0 & 2047;
      const float* tb = fs + part * 4096;
      float v[8];
#pragma unroll
      for (int e = 0; e < 8; ++e) v[e] = tb[(k * (jj + e)) & 4095];
      if (part == 1 && jj == 0) v[0] = (k & 1) ? -1.f : 1.f;
      u32x4 o; o[0] = pk2(v[0], v[1]); o[1] = pk2(v[2], v[3]); o[2] = pk2(v[4], v[5]); o[3] = pk2(v[6], v[7]);
      *(u32x4*)(DS + (size_t)k * 4096 + j0) = o;
    }
    u16* DP = (u16*)(p.ws + WS_DFTP);
    for (int i = bid * 512 + tid; i < 256 * 64; i += G * 512) {
      const int k = i >> 6, j0 = (i & 63) * 8; const int part = j0 >> 8, jj = j0 & 255;
      const float* tb = fs + part * 4096;
      float v[8];
#pragma unroll
      for (int e = 0; e < 8; ++e) v[e] = tb[((k * (jj + e)) & 255) * 16];
      u32x4 o; o[0] = pk2(v[0], v[1]); o[1] = pk2(v[2], v[3]); o[2] = pk2(v[4], v[5]); o[3] = pk2(v[6], v[7]);
      *(u32x4*)(DP + (size_t)k * 512 + j0) = o;
    }
  }
}

__device__ __forceinline__ void phase_fold(const P& p, const int tid) {
  const u16* UT = (const u16*)(p.ws + WS_UT) + UT_SAMPLE_OFF; u16* UF = (u16*)(p.ws + WS_H);
  for (int it = blockIdx.x * 512 + tid; it < 2048 * 512; it += gridDim.x * 512) {
    const int n = it >> 9, c = it & 511, part = c >> 8, cc = c & 255;
    const u16* base = UT + (size_t)n * 8192 + part * 4096;
    const u32x4 f = *(const u32x4*)(base + 8 * cc), g = *(const u32x4*)(base + 4096 - 8 * cc - 8);
    float fw[8], bw[8];
#pragma unroll
    for (int e = 0; e < 4; ++e) { fw[2 * e] = bflo(f[e]); fw[2 * e + 1] = bfhi(f[e]); }
    float gv[8];
#pragma unroll
    for (int e = 0; e < 4; ++e) { gv[2 * e] = bflo(g[e]); gv[2 * e + 1] = bfhi(g[e]); }
#pragma unroll
    for (int e = 1; e < 8; ++e) bw[e] = gv[8 - e];
    bw[0] = cc ? bf2f(base[4096 - 8 * cc]) : 0.f;
    float o[8];
#pragma unroll
    for (int e = 0; e < 8; ++e) o[e] = part ? fw[e] - bw[e] : fw[e] + bw[e];
    if (cc == 0) o[0] = part ? bf2f(UT[(size_t)n * 8192 + 2048]) : fw[0];
    u32x4 ov; ov[0] = pk2(o[0], o[1]); ov[1] = pk2(o[2], o[3]); ov[2] = pk2(o[4], o[5]); ov[3] = pk2(o[6], o[7]);
    *(u32x4*)(UF + (size_t)n * 4096 + part * 2048 + 8 * cc) = ov;
  }
}

__device__ __forceinline__ void phase_h(const P& p, int l, bool first, const int tid) {
  const int lane = tid & 63, gw = blockIdx.x * 8 + (tid >> 6), ngw = gridDim.x * 8;
  const float* modl = (const float*)(p.ws + WS_MOD) + (size_t)l * 5 * 3072;
  u16* H = (u16*)(p.ws + WS_H);
  float pef[4] = {0.f, 0.f, 0.f, 0.f};
  if (first) {
#pragma unroll
    for (int e = 0; e < 4; ++e) pef[e] = 1.0f / powf(10000.0f, (float)(4 * lane + e) / 256.0f);
  }
  for (int r = gw; r < NTOK; r += ngw) {
    const int j = r < NPROMPT ? 0 : 1 + ((r - NPROMPT) >> 12);
    float* xr = p.out + (size_t)r * 1024;
    f32x4 v[4];
    if (first) {
      const float* src = r < NPROMPT ? p.x_prompt + (size_t)r * 1024 : p.x_sample + (size_t)(r - NPROMPT) * 1024;
#pragma unroll
      for (int i = 0; i < 4; ++i) v[i] = *(const f32x4*)(src + 4 * (lane + 64 * i));
      if (r >= NPROMPT) {
        const int pos = (r - NPROMPT) & 4095; const float pr = (float)(pos >> 6), pc = (float)(pos & 63);
#pragma unroll
        for (int e = 0; e < 4; ++e) {
          const float fr_ = pef[e];
          v[0][e] += sinf(pr * fr_); v[1][e] += cosf(pr * fr_); v[2][e] += sinf(pc * fr_); v[3][e] += cosf(pc * fr_);
        }
      }
#pragma unroll
      for (int i = 0; i < 4; ++i) *(f32x4*)(xr + 4 * (lane + 64 * i)) = v[i];
    } else {
#pragma unroll
      for (int i = 0; i < 4; ++i) v[i] = *(const f32x4*)(xr + 4 * (lane + 64 * i));
    }
    float ss = 0.f;
#pragma unroll
    for (int i = 0; i < 4; ++i) ss += (v[i][0] * v[i][0] + v[i][1] * v[i][1]) + (v[i][2] * v[i][2] + v[i][3] * v[i][3]);
    const float rstd = rsqrtf(wave_sum(ss) * (1.f / 1024.f) + 1e-6f);
#pragma unroll
    for (int i = 0; i < 4; ++i) {
      const int e0 = 4 * (lane + 64 * i);
      const f32x4 nw = *(const f32x4*)(p.norm_w + l * 1024 + e0), sh = *(const f32x4*)(modl + j * 3072 + e0), sc = *(const f32x4*)(modl + j * 3072 + 1024 + e0);
      f32x4 hh;
#pragma unroll
      for (int e = 0; e < 4; ++e) hh[e] = (v[i][e] * rstd) * nw[e] * (1.f + sc[e]) + sh[e];
      u32x2 o; o[0] = pk2(hh[0], hh[1]); o[1] = pk2(hh[2], hh[3]);
      *(u32x2*)(H + (size_t)r * 1024 + e0) = o;
    }
  }
}

constexpr int SC_QB = 0, SC_KB = 8704, SC_KLT = 17408, SC_DEC = 26624, SC_EM = 27136, SC_P = 27648, SC_QA = 29184, SC_BUF = 37888;
__device__ __forceinline__ float ex2(float x) { return __builtin_amdgcn_exp2f(x); }
__device__ __forceinline__ void scan_chain(const P& p, int l, int seq, int hh, int dir, int mode, int seg, unsigned char* shm, int& parity, const int tid) {
  const int w = tid >> 6, lane = tid & 63, fr = lane & 15, fq = lane >> 4;
  const bool samp = seq >= 32;
  const int L = samp ? 4096 : 256, rowbase = samp ? NPROMPT + (seq - 32) * 4096 : seq * 256, nch = mode ? 32 : (L >> 5), n0 = mode ? seg * 32 : 0;
  const int chain = (seq - 32) * 16 + hh * 2 + dir;
  const long cstep = dir ? -32 * 1024 : 32 * 1024;
  const long rstr = dir ? -1024 : 1024;
  const size_t e0 = (size_t)((long)((size_t)rowbase + (dir ? L - 1 : 0)) * 1024 + hh * 128 + (long)n0 * cstep);
  const u16* Qc = (const u16*)(p.ws + WS_Q) + e0;
  const u16* LFc = (const u16*)(p.ws + (dir ? WS_LB : WS_LF)) + e0;
  const u16* Vc = (const u16*)(p.ws + WS_V) + e0;
  u16* Oc = (u16*)(p.ws + (dir ? WS_OB : WS_OF)) + e0;
  const int sg = dir ? -1 : 1;
  const int off_t = sg * (fq * 8) * 1024 + w * 16 + fr;
  const int off_c0 = sg * fr * 1024 + w * 16 + fq * 4;
  const int off_v = sg * (fq * 4) * 1024 + w * 16 + fr;
  f32x4 S[8];
  if (mode == 1 || !samp) {
#pragma unroll
    for (int cb = 0; cb < 8; ++cb) S[cb] = (f32x4){0.f, 0.f, 0.f, 0.f};
  } else {
    const float* s0 = p.state + ((((size_t)(seq - 32) * 4 + l) * 2 + dir) * 8 + hh) * 16384 + w * 16 + fr;
#pragma unroll
    for (int cb = 0; cb < 8; ++cb)
#pragma unroll
      for (int j = 0; j < 4; ++j) S[cb][j] = s0[(cb * 16 + fq * 4 + j) * 128];
    for (int g = 0; g < seg; ++g) {
      const float* sl = (const float*)(p.ws + WS_SLOC) + ((size_t)chain * 3 + g) * 16384 + w * 16 + fr;
      const float* lg = (const float*)(p.ws + WS_LSEG) + ((size_t)chain * 3 + g) * 128 + fq * 4;
#pragma unroll
      for (int cb = 0; cb < 8; ++cb) { const f32x4 lv4 = *(const f32x4*)(lg + cb * 16);
#pragma unroll
        for (int j = 0; j < 4; ++j) S[cb][j] = ex2(lv4[j]) * S[cb][j] + sl[(cb * 16 + fq * 4 + j) * 128]; }
    }
  }
  f32x4 lsum = {0.f, 0.f, 0.f, 0.f};
  bf16x8 Lm[2];
#pragma unroll
  for (int tb = 0; tb < 2; ++tb)
#pragma unroll
    for (int j = 0; j < 8; ++j) Lm[tb][j] = (fq * 8 + j <= tb * 16 + fr) ? (short)0x3F80 : (short)0;
  u16 n_lft[8], n_v[8]; u32x2 n_lfc[2], n_qc[2] = {{0u, 0u}, {0u, 0u}};
#define SC_LOAD(QP, LP, VP) do { \
    _Pragma("unroll") for (int j = 0; j < 8; ++j) n_lft[j] = ((LP) + j * rstr)[off_t]; \
    _Pragma("unroll") for (int tb = 0; tb < 2; ++tb) { n_lfc[tb] = *(const u32x2*)((LP) + tb * 16 * rstr + off_c0); if (mode != 1) n_qc[tb] = *(const u32x2*)((QP) + tb * 16 * rstr + off_c0); } \
    _Pragma("unroll") for (int i = 0; i < 8; ++i) n_v[i] = ((VP) + ((i >> 2) * 16 + (i & 3)) * rstr)[off_v]; } while (0)
  SC_LOAD(Qc, LFc, Vc);
  for (int n = 0; n < nch; ++n) {
    u16 lft[8], vv[8]; u32x2 lfc[2], qc[2];
#pragma unroll
    for (int j = 0; j < 8; ++j) { lft[j] = n_lft[j]; vv[j] = n_v[j]; }
    lfc[0] = n_lfc[0]; lfc[1] = n_lfc[1]; qc[0] = n_qc[0]; qc[1] = n_qc[1];
    u16* Ocur = Oc;
    Qc += cstep; LFc += cstep; Vc += cstep; Oc += cstep;
    if (n + 1 < nch) SC_LOAD(Qc, LFc, Vc);
    unsigned char* buf = shm + (parity & 1) * SC_BUF; parity ^= 1;
    bf16x8 ahi, alo, vop;
    {
      unsigned hb[8], lb2[8];
#pragma unroll
      for (int j = 0; j < 8; ++j) { const float x = h2f(lft[j]); const unsigned xb = __float_as_uint(x) & 0xFFFF0000u; hb[j] = xb; lb2[j] = __float_as_uint(x - __uint_as_float(xb)); }
      u32x4 ph, pl, pv;
#pragma unroll
      for (int j = 0; j < 4; ++j) { ph[j] = (hb[2 * j] >> 16) | hb[2 * j + 1]; pl[j] = (lb2[2 * j] >> 16) | (lb2[2 * j + 1] & 0xFFFF0000u); pv[j] = (unsigned)vv[2 * j] | ((unsigned)vv[2 * j + 1] << 16); }
      ahi = __builtin_bit_cast(bf16x8, ph); alo = __builtin_bit_cast(bf16x8, pl); vop = __builtin_bit_cast(bf16x8, pv);
    }
    f32x4 b[2];
#pragma unroll
    for (int tb = 0; tb < 2; ++tb) {
      b[tb] = __builtin_amdgcn_mfma_f32_16x16x32_bf16(ahi, Lm[tb], (f32x4){0.f, 0.f, 0.f, 0.f}, 0, 0, 0);
      b[tb] = __builtin_amdgcn_mfma_f32_16x16x32_bf16(alo, Lm[tb], b[tb], 0, 0, 0);
    }
    f32x4 blast, bmid, elm, emc;
#pragma unroll
    for (int j = 0; j < 4; ++j) { blast[j] = __shfl(b[1][j], (lane & 48) | 15); bmid[j] = __shfl(b[0][j], (lane & 48) | 15); elm[j] = ex2(blast[j] - bmid[j]); emc[j] = ex2(bmid[j]); }
    lsum += blast;
#pragma unroll
    for (int tb = 0; tb < 2; ++tb) {
      float qv[4], lv[4], qb[4], kb[4], kl[4];
      qv[0] = bflo(qc[tb][0]); qv[1] = bfhi(qc[tb][0]); qv[2] = bflo(qc[tb][1]); qv[3] = bfhi(qc[tb][1]);
      lv[0] = h2f((u16)(lfc[tb][0] & 0xFFFF)); lv[1] = h2f((u16)(lfc[tb][0] >> 16)); lv[2] = h2f((u16)(lfc[tb][1] & 0xFFFF)); lv[3] = h2f((u16)(lfc[tb][1] >> 16));
#pragma unroll
      for (int j = 0; j < 4; ++j) { const float kk = 1.f - ex2(lv[j]), d = b[tb][j] - bmid[j]; qb[j] = qv[j] * ex2(d); kb[j] = kk * ex2(-d); kl[j] = kb[j] * elm[j]; }
      if (mode != 1) {
        u32x2 o; o[0] = pk2(qb[0], qb[1]); o[1] = pk2(qb[2], qb[3]);
        *(u32x2*)(buf + SC_QB + (tb * 16 + fr) * 272 + (w * 16 + fq * 4) * 2) = o;
        o[0] = pk2(qb[0] * emc[0], qb[1] * emc[1]); o[1] = pk2(qb[2] * emc[2], qb[3] * emc[3]);
        *(u32x2*)(buf + SC_QA + (tb * 16 + fr) * 272 + (w * 16 + fq * 4) * 2) = o;
        o[0] = pk2(kb[0], kb[1]); o[1] = pk2(kb[2], kb[3]);
        *(u32x2*)(buf + SC_KB + (tb * 16 + fr) * 272 + (w * 16 + fq * 4) * 2) = o;
      }
      const unsigned k01 = pk2(kl[0], kl[1]), k23 = pk2(kl[2], kl[3]);
      unsigned char* kp = buf + SC_KLT + (w * 16 + fq * 4) * 72 + (tb * 16 + fr) * 2;
      *(u16*)(kp) = (u16)(k01 & 0xFFFFu); *(u16*)(kp + 72) = (u16)(k01 >> 16); *(u16*)(kp + 144) = (u16)(k23 & 0xFFFFu); *(u16*)(kp + 216) = (u16)(k23 >> 16);
    }
    if (fr == 0) { f32x4 d;
#pragma unroll
      for (int j = 0; j < 4; ++j) d[j] = emc[j] * elm[j];
      *(f32x4*)(buf + SC_DEC + (w * 16 + fq * 4) * 4) = d; }
    __syncthreads();
    f32x4 o0 = {0.f, 0.f, 0.f, 0.f}, o1 = o0;
    if (mode != 1) {
      if (w < 3) {
        __builtin_amdgcn_s_setprio(3);
        const int krow = (w == 2 ? 16 : 0) + fr, qrow = (w == 0 ? 0 : 16) + fr;
        f32x4 at = {0.f, 0.f, 0.f, 0.f};
#pragma unroll
        for (int kbk = 0; kbk < 4; ++kbk) {
          const bf16x8 kf = *(const bf16x8*)(buf + SC_KB + krow * 272 + kbk * 64 + fq * 16), qf = *(const bf16x8*)(buf + SC_QB + qrow * 272 + kbk * 64 + fq * 16);
          at = __builtin_amdgcn_mfma_f32_16x16x32_bf16(kf, qf, at, 0, 0, 0);
        }
        if (w != 1) {
#pragma unroll
          for (int j = 0; j < 4; ++j) at[j] = (fq * 4 + j <= fr) ? at[j] : 0.f;
        }
        u32x2 pw; pw[0] = pk2(at[0], at[1]); pw[1] = pk2(at[2], at[3]);
        *(u32x2*)(buf + SC_P + w * 512 + lane * 8) = pw;
        __builtin_amdgcn_s_setprio(0);
      }
#pragma unroll
      for (int kbk = 0; kbk < 4; ++kbk) {
        u32x4 sp; sp[0] = pk2(S[2 * kbk][0], S[2 * kbk][1]); sp[1] = pk2(S[2 * kbk][2], S[2 * kbk][3]); sp[2] = pk2(S[2 * kbk + 1][0], S[2 * kbk + 1][1]); sp[3] = pk2(S[2 * kbk + 1][2], S[2 * kbk + 1][3]);
        const bf16x8 sop = __builtin_bit_cast(bf16x8, sp);
        u32x4 qa, qb2;
        { const u32x2 x0 = *(const u32x2*)(buf + SC_QA + fr * 272 + kbk * 64 + fq * 8), x1 = *(const u32x2*)(buf + SC_QA + fr * 272 + kbk * 64 + 32 + fq * 8); qa[0] = x0[0]; qa[1] = x0[1]; qa[2] = x1[0]; qa[3] = x1[1]; }
        { const u32x2 x0 = *(const u32x2*)(buf + SC_QA + (16 + fr) * 272 + kbk * 64 + fq * 8), x1 = *(const u32x2*)(buf + SC_QA + (16 + fr) * 272 + kbk * 64 + 32 + fq * 8); qb2[0] = x0[0]; qb2[1] = x0[1]; qb2[2] = x1[0]; qb2[3] = x1[1]; }
        o0 = __builtin_amdgcn_mfma_f32_16x16x32_bf16(__builtin_bit_cast(bf16x8, qa), sop, o0, 0, 0, 0);
        o1 = __builtin_amdgcn_mfma_f32_16x16x32_bf16(__builtin_bit_cast(bf16x8, qb2), sop, o1, 0, 0, 0);
      }
    }
#pragma unroll
    for (int cb = 0; cb < 8; ++cb) {
      const f32x4 d = *(const f32x4*)(buf + SC_DEC + (cb * 16 + fq * 4) * 4);
      u32x4 ka; { const u32x2 x0 = *(const u32x2*)(buf + SC_KLT + (cb * 16 + fr) * 72 + fq * 8), x1 = *(const u32x2*)(buf + SC_KLT + (cb * 16 + fr) * 72 + 32 + fq * 8); ka[0] = x0[0]; ka[1] = x0[1]; ka[2] = x1[0]; ka[3] = x1[1]; }
      S[cb] = __builtin_amdgcn_mfma_f32_16x16x32_bf16(__builtin_bit_cast(bf16x8, ka), vop, d * S[cb], 0, 0, 0);
    }
    if (mode != 1) {
      __syncthreads();
      const u32x2 t0 = *(const u32x2*)(buf + SC_P + lane * 8), t1 = *(const u32x2*)(buf + SC_P + 512 + lane * 8), t2 = *(const u32x2*)(buf + SC_P + 1024 + lane * 8);
      u32x4 pp; pp[0] = t0[0]; pp[1] = t0[1]; pp[2] = 0u; pp[3] = 0u;
      o0 = __builtin_amdgcn_mfma_f32_16x16x32_bf16(__builtin_bit_cast(bf16x8, pp), vop, o0, 0, 0, 0);
      pp[0] = t1[0]; pp[1] = t1[1]; pp[2] = t2[0]; pp[3] = t2[1];
      o1 = __builtin_amdgcn_mfma_f32_16x16x32_bf16(__builtin_bit_cast(bf16x8, pp), vop, o1, 0, 0, 0);
#pragma unroll
      for (int j = 0; j < 4; j += 2) { const unsigned a = pk2(o0[j], o0[j + 1]), b = pk2(o1[j], o1[j + 1]);
        (Ocur + j * rstr)[off_v] = (u16)(a & 0xFFFFu); (Ocur + (j + 1) * rstr)[off_v] = (u16)(a >> 16); (Ocur + (16 + j) * rstr)[off_v] = (u16)(b & 0xFFFFu); (Ocur + (17 + j) * rstr)[off_v] = (u16)(b >> 16); }
    }
  }
#undef SC_LOAD
  if (mode == 1) {
    float* sl = (float*)(p.ws + WS_SLOC) + ((size_t)chain * 3 + seg) * 16384 + w * 16 + fr;
#pragma unroll
    for (int cb = 0; cb < 8; ++cb)
#pragma unroll
      for (int j = 0; j < 4; ++j) sl[(cb * 16 + fq * 4 + j) * 128] = S[cb][j];
    if (fr == 0) *(f32x4*)((float*)(p.ws + WS_LSEG) + ((size_t)chain * 3 + seg) * 128 + w * 16 + fq * 4) = lsum;
  }
  if (!samp) {
    float* ns = p.out + (size_t)NTOK * 1024 + ((((size_t)seq * 4 + l) * 2 + dir) * 8 + hh) * 16384 + w * 16 + fr;
#pragma unroll
    for (int cb = 0; cb < 8; ++cb)
#pragma unroll
      for (int j = 0; j < 4; ++j) ns[(cb * 16 + fq * 4 + j) * 128] = S[cb][j];
  }
}

__device__ __forceinline__ void phase_fin(const P& p, int l, const int tid) {
  const int lane = tid & 63, gw = blockIdx.x * 8 + (tid >> 6), ngw = gridDim.x * 8;
  const u16* OF = (const u16*)(p.ws + WS_OF); const u16* OB = (const u16*)(p.ws + WS_OB);
  const u16* ZA = (const u16*)(p.ws + WS_ZA); u16* YA = (u16*)(p.ws + WS_YAB);
  const float* gw_ = p.gnorm_w + l * 1024 + lane * 16;
  for (int r = gw; r < NTOK; r += ngw) {
    const size_t base = (size_t)r * 1024 + lane * 16;
    const u32x4 f0 = *(const u32x4*)(OF + base), f1 = *(const u32x4*)(OF + base + 8), b0 = *(const u32x4*)(OB + base), b1 = *(const u32x4*)(OB + base + 8);
    f32x4 o[4]; float ss = 0.f;
#pragma unroll
    for (int i = 0; i < 2; ++i) {
      o[i][0] = bflo(f0[2 * i]) + bflo(b0[2 * i]); o[i][1] = bfhi(f0[2 * i]) + bfhi(b0[2 * i]); o[i][2] = bflo(f0[2 * i + 1]) + bflo(b0[2 * i + 1]); o[i][3] = bfhi(f0[2 * i + 1]) + bfhi(b0[2 * i + 1]);
      o[2 + i][0] = bflo(f1[2 * i]) + bflo(b1[2 * i]); o[2 + i][1] = bfhi(f1[2 * i]) + bfhi(b1[2 * i]); o[2 + i][2] = bflo(f1[2 * i + 1]) + bflo(b1[2 * i + 1]); o[2 + i][3] = bfhi(f1[2 * i + 1]) + bfhi(b1[2 * i + 1]); }
#pragma unroll
    for (int i = 0; i < 4; ++i) ss += (o[i][0] * o[i][0] + o[i][1] * o[i][1]) + (o[i][2] * o[i][2] + o[i][3] * o[i][3]);
    ss += __shfl_xor(ss, 1); ss += __shfl_xor(ss, 2); ss += __shfl_xor(ss, 4);
    const float rstd = rsqrtf(ss * (1.f / 128.f) + 1e-6f);
    const u32x4 z0 = *(const u32x4*)(ZA + base), z1 = *(const u32x4*)(ZA + base + 8);
    float zf[16];
#pragma unroll
    for (int i = 0; i < 4; ++i) { zf[2 * i] = bflo(z0[i]); zf[2 * i + 1] = bfhi(z0[i]); zf[8 + 2 * i] = bflo(z1[i]); zf[8 + 2 * i + 1] = bfhi(z1[i]); }
    float y[16];
#pragma unroll
    for (int i = 0; i < 4; ++i) { const f32x4 g = *(const f32x4*)(gw_ + 4 * i);
#pragma unroll
      for (int e = 0; e < 4; ++e) y[4 * i + e] = o[i][e] * rstd * g[e] * zf[4 * i + e]; }
    u32x4 a, b2;
    a[0] = pk2(y[0], y[1]); a[1] = pk2(y[2], y[3]); a[2] = pk2(y[4], y[5]); a[3] = pk2(y[6], y[7]);
    b2[0] = pk2(y[8], y[9]); b2[1] = pk2(y[10], y[11]); b2[2] = pk2(y[12], y[13]); b2[3] = pk2(y[14], y[15]);
    *(u32x4*)(YA + (size_t)r * 1536 + lane * 16) = a; *(u32x4*)(YA + (size_t)r * 1536 + lane * 16 + 8) = b2;
  }
}

__device__ __forceinline__ void phase_final(const P& p, const int tid) {
  const int lane = tid & 63, gw = blockIdx.x * 8 + (tid >> 6), ngw = gridDim.x * 8;
  for (int r = gw; r < NTOK; r += ngw) {
    float* xr = p.out + (size_t)r * 1024;
    f32x4 v[4]; float ss = 0.f;
#pragma unroll
    for (int i = 0; i < 4; ++i) { v[i] = *(const f32x4*)(xr + 4 * (lane + 64 * i)); ss += (v[i][0] * v[i][0] + v[i][1] * v[i][1]) + (v[i][2] * v[i][2] + v[i][3] * v[i][3]); }
    const float rstd = rsqrtf(wave_sum(ss) * (1.f / 1024.f) + 1e-6f);
#pragma unroll
    for (int i = 0; i < 4; ++i) { const f32x4 fw = *(const f32x4*)(p.final_w + 4 * (lane + 64 * i)); *(f32x4*)(xr + 4 * (lane + 64 * i)) = v[i] * rstd * fw; }
  }
}

#define XB_TMO      128
#define XB_XCNT(j)  (256  + 64 * (j))
#define XB_XSUB(j)  (1280 + 64 * (j))
#define XB_XGEN(j)  (2304 + 64 * (j))
#define XB_TOP      3328
#define XB_TOPGEN   3392
#define XCD_BAR_WORDS 3456
#define XB_SPIN_CAP (1u << 18)
__device__ __forceinline__ unsigned xb_ld(unsigned* p)              { return __hip_atomic_load(p, __ATOMIC_RELAXED, __HIP_MEMORY_SCOPE_AGENT); }
__device__ __forceinline__ unsigned xb_add(unsigned* p, unsigned v) { return __hip_atomic_fetch_add(p, v, __ATOMIC_RELAXED, __HIP_MEMORY_SCOPE_AGENT); }
__device__ __forceinline__ unsigned xb_xcc_id() { return (unsigned)__builtin_amdgcn_s_getreg((3 << 11) | 20) & 0xFu; }
#define XB_SPIN(cond, bar) do { unsigned _sp = 0; while (cond) { __builtin_amdgcn_s_sleep(1); \
    if ((++_sp & 255u) == 0u) { if (xb_ld(&(bar)[XB_TMO])) break; if (_sp > XB_SPIN_CAP) { atomicAdd(&(bar)[XB_TMO], 1u); break; } } } } while (0)
__device__ __forceinline__ void xcd_barrier_complete(unsigned* bar, unsigned x, unsigned& nloc, unsigned& nx) {
    const unsigned G = gridDim.x * gridDim.y * gridDim.z;
    unsigned sum, cnt, mine, sp = 0u;
    for (;;) {
        sum = 0u; cnt = 0u; mine = 0u;
#pragma unroll
        for (unsigned j = 0; j < 16; ++j) { const unsigned c = xb_ld(&bar[XB_XCNT(j)]); sum += c; cnt += (c > 0u) ? 1u : 0u; mine = (j == x) ? c : mine; }
        if (sum == G) break;
        __builtin_amdgcn_s_sleep(1);
        if ((++sp & 255u) == 0u) { if (xb_ld(&bar[XB_TMO])) break; if (sp > XB_SPIN_CAP) { atomicAdd(&bar[XB_TMO], 1u); break; } }
    }
    nloc = mine > 0u ? mine : 1u; nx = cnt > 0u ? cnt : 1u;
}
__device__ __forceinline__ void xcd_barrier(unsigned* bar, volatile LAS unsigned* st, const int tid) {
    asm volatile("s_waitcnt vmcnt(0)" ::: "memory");
    __syncthreads();
    if (tid == 0) {
        const unsigned x = xb_xcc_id();
        __builtin_amdgcn_s_waitcnt(0);
        unsigned nloc = st[0], nx = st[1];
        if (nloc == 0u) { xcd_barrier_complete(bar, x, nloc, nx); st[0] = nloc; st[1] = nx; }
        const unsigned old = xb_add(&bar[XB_XSUB(x)], 1u);
        const unsigned gen = old / nloc;
        if (old + 1u == (gen + 1u) * nloc) {
            __builtin_amdgcn_fence(__ATOMIC_RELEASE, "agent");
            asm volatile("s_waitcnt vmcnt(0)" ::: "memory");
            const unsigned og = xb_add(&bar[XB_TOP], 1u);
            const unsigned tg = og / nx;
            if (og + 1u == (tg + 1u) * nx) xb_add(&bar[XB_TOPGEN], 1u);
            else XB_SPIN(xb_ld(&bar[XB_TOPGEN]) == tg, bar);
            __builtin_amdgcn_fence(__ATOMIC_ACQUIRE, "agent");
            xb_add(&bar[XB_XGEN(x)], 1u);
            asm volatile("s_waitcnt vmcnt(0)" ::: "memory");
        } else {
            XB_SPIN(xb_ld(&bar[XB_XGEN(x)]) == gen, bar);
            __builtin_amdgcn_fence(__ATOMIC_ACQUIRE, "agent");
            asm volatile("s_waitcnt vmcnt(0)" ::: "memory");
        }
    }
    __syncthreads();
}

struct EpiAll {
  int type, perm;
  unsigned char* ws; float* x; const float* f0; int rowbase, lshift; float scale; int pm0;
  __device__ __forceinline__ void operator()(const Acc& acc, const Unit& u0, int wr, int wc, int fr, int fq) const {
    asm volatile("" : "+v"(fr), "+v"(fq));
    Unit u = u0; u.pm += pm0;
    switch (type) {
      case 0: { EpiG1 E{ws, f0}; E(acc, u, wr, wc, fr, fq); break; }
      case 1: { EpiDFT E{ws, rowbase, lshift, scale}; E(acc, u, wr, wc, fr, fq); break; }
      case 2: { EpiG2 E{ws}; E(acc, u, wr, wc, fr, fq); break; }
      default: { EpiG3 E{x, f0}; E(acc, u, wr, wc, fr, fq); break; }
    }
  }
  __device__ __forceinline__ void hook(Acc& acc, const Unit& u0, int wr, int wc, int fr, int fq) const {
    asm volatile("" : "+v"(fr), "+v"(fq));
    Unit u = u0; u.pm += pm0;
    EpiG2 E{ws}; E.hook(acc, u, wr, wc, fr, fq);
  }
};

__global__ void __launch_bounds__(512, 2) fwd_megakernel(P p_arg) {
#if defined(__HIP_DEVICE_COMPILE__)
  extern __shared__ __attribute__((aligned(16))) unsigned char shm[];
  cg::grid_group grid = cg::this_grid();
  LAS unsigned char* lds = (LAS unsigned char*)shm;
  const int bid = blockIdx.x, G = gridDim.x;
  volatile LAS unsigned* xb_st = (volatile LAS unsigned*)(lds + 131072);
  if (threadIdx.x == 0) { xb_st[0] = 0u; xb_st[1] = 0u; }
  __syncthreads();
  for (int si = 0; si < 64; ++si) {
    const __attribute__((address_space(4))) P* pp = (const __attribute__((address_space(4))) P*)__builtin_amdgcn_kernarg_segment_ptr(); asm volatile("" : "+s"(pp));
    const unsigned code = pp->prog[si];
    if (code == 0xFFu) break;
    P p;
    p.x_prompt = pp->x_prompt; p.x_sample = pp->x_sample; p.state = pp->state; p.c = pp->c; p.c_ctx = pp->c_ctx; p.norm_w = pp->norm_w; p.w_ada = pp->w_ada; p.b_ada = pp->b_ada; p.w_in = pp->w_in;
    p.lb_raw = pp->lb_raw; p.gnorm_w = pp->gnorm_w; p.w_pa = pp->w_pa; p.w_pb = pp->w_pb; p.w_o = pp->w_o; p.final_w = pp->final_w; p.out = pp->out; p.ws = pp->ws;
    unsigned char* ws = p.ws;
    int tid = threadIdx.x; asm volatile("" : "+v"(tid));
    const int k = code & 15, l = (code >> 4) & 3;
    if (k == 8) { if (bid == 0) for (int i = tid; i < XCD_BAR_WORDS; i += 512) ((unsigned*)ws)[i] = 0u;
      p0_prologue(p, shm, tid); }
    else if (k == 9) { phase_final(p, tid); }
    else if (k == 0) phase_h(p, l, l == 0, tid);
    else if (k == 3) {
      int parity = 0;
      if (bid < 128) { for (int ci = 256 + bid * 2; ci < 256 + bid * 2 + 2; ++ci) scan_chain(p, l, ci >> 4, (ci >> 1) & 7, ci & 1, 0, 0, shm, parity, tid); }
      else {
        const int b2 = bid - 128;
        for (int ci = b2 * 2; ci < b2 * 2 + 2; ++ci) scan_chain(p, l, ci >> 4, (ci >> 1) & 7, ci & 1, 0, 0, shm, parity, tid);
        const int a0 = b2 < 64 ? b2 : 64 + (b2 - 64) * 2, an = b2 < 64 ? 1 : 2;
        for (int ai = a0; ai < a0 + an; ++ai) { const int ch = ai / 3, sg = ai - ch * 3; scan_chain(p, l, 32 + (ch >> 4), (ch >> 1) & 7, ch & 1, 1, sg, shm, parity, tid); }
      }
    }
    else if (k == 11) {
      int parity = 0; const int ch = bid >> 2, sg = bid & 3;
      scan_chain(p, l, 32 + (ch >> 4), (ch >> 1) & 7, ch & 1, 2, sg, shm, parity, tid);
    }
    else if (k == 4) phase_fin(p, l, tid);
    else if (k == 10) { }
    else if (k == 12) phase_fold(p, tid);
    else {
      Gemm g; StaticOrder S; EpiAll E; E.ws = ws; E.x = p.out; E.f0 = nullptr; E.rowbase = 0; E.lshift = 0; E.scale = 0.f; E.pm0 = 0;
      if (k == 1) { g = Gemm{(const u16*)(ws + WS_H), (const u16*)(ws + WS_WIN) + (size_t)l * NG1 * 1024, NTOK, NG1, 1024}; S.init(NTOK, NG1, G, bid);
        E.type = 0; E.perm = 1; E.f0 = (const float*)(ws + WS_LBS) + l * 2048; }
      else if (k == 2) {
        E.type = 1; E.perm = 1;
        if (bid < 128) { g = Gemm{(const u16*)(ws + WS_DFTS), (const u16*)(ws + WS_H), 4096, 2048, 4096}; S.init(4096, 2048, 128, bid);
          E.rowbase = NPROMPT; E.lshift = 12; E.scale = 0.001381067932f; }
        else { g = Gemm{(const u16*)(ws + WS_DFTP), (const u16*)(ws + WS_UT), 256, 16384, 512}; S.init(256, 16384, 64, bid < 192 ? bid - 128 : -1);
          E.rowbase = 0; E.lshift = 8; E.scale = 0.005524271728f; }
      }
      else {
        const bool isG2 = (k == 5) || (k == 6 && bid < 128);
        const int p0 = (k == 5) ? 0 : (k == 6 ? (bid < 128 ? 64 : 0) : 32), np = (k == 6) ? 32 : 64;
        const int gsz = (k == 6) ? 128 : G, gc = (k == 6 && bid >= 128) ? bid - 128 : bid;
        E.pm0 = p0; E.perm = 0;
        if (isG2) { g = Gemm{(const u16*)(ws + WS_YAB) + (size_t)p0 * 256 * 1536, (const u16*)(ws + WS_WPA) + (size_t)l * 1024 * 1536, np * 256, 1024, 1536}; E.type = 2; }
        else { g = Gemm{(const u16*)(ws + WS_MERGED) + (size_t)p0 * 256 * 1024, (const u16*)(ws + WS_WO) + (size_t)l * 1024 * 1024, np * 256, 1024, 1024}; E.type = 4; E.f0 = (const float*)(ws + WS_MOD) + (size_t)l * 5 * 3072; }
        S.init(np * 256, 1024, gsz, gc);
      }
      pg8::gemm_phase(lds, g, S, E, tid);
      __syncthreads();
    }
    if (code & 0x80u) {
      if (k == 8) { grid.sync(); if (tid == 0) (void)xb_add(&((unsigned*)ws)[XB_XCNT(xb_xcc_id())], 1u); }
      else xcd_barrier((unsigned*)ws, xb_st, tid);
    }
  }
#endif
}

extern "C" void kernel_launch(void* const* d_in, const int* in_sizes, int n_in, void* d_out, int out_size,
                              void* d_ws, size_t ws_size, hipStream_t stream) {
  static int grid_blocks = 0;
  if (!grid_blocks) {
    int dev = 0, cus = 0, per_cu = 0;
    if (n_in != 15 || ws_size < WS_END) { fprintf(stderr, "kernel_launch: unexpected inputs / workspace (%d, %zu)\n", n_in, ws_size); grid_blocks = -1; return; }
    (void)hipGetDevice(&dev);
    (void)hipDeviceGetAttribute(&cus, hipDeviceAttributeMultiprocessorCount, dev);
    (void)hipFuncSetAttribute((const void*)fwd_megakernel, hipFuncAttributeMaxDynamicSharedMemorySize, LDS_BYTES);
    (void)hipOccupancyMaxActiveBlocksPerMultiprocessor(&per_cu, (const void*)fwd_megakernel, 512, LDS_BYTES);
    if (per_cu < 1 || cus < 256) { fprintf(stderr, "kernel_launch: occupancy %d x %d CUs cannot hold the 256-workgroup grid\n", per_cu, cus); grid_blocks = -1; return; }
    grid_blocks = 256;
  }
  if (grid_blocks < 0) return;
  P p{};
  p.x_prompt = (const float*)d_in[0]; p.x_sample = (const float*)d_in[1]; p.state = (const float*)d_in[2]; p.c = (const float*)d_in[3]; p.c_ctx = (const float*)d_in[4];
  p.norm_w = (const float*)d_in[5]; p.w_ada = (const float*)d_in[6]; p.b_ada = (const float*)d_in[7]; p.w_in = (const float*)d_in[8]; p.lb_raw = (const float*)d_in[9];
  p.gnorm_w = (const float*)d_in[10]; p.w_pa = (const float*)d_in[11]; p.w_pb = (const float*)d_in[12]; p.w_o = (const float*)d_in[13]; p.final_w = (const float*)d_in[14];
  p.out = (float*)d_out; p.ws = (unsigned char*)d_ws;
  {
#ifndef REPMASK
#define REPMASK 0
#endif
    static const unsigned char nosync[13] = {0, 0, 1, 0, 0, 0, 0, 0, 0, 1, 0, 0, 0};
    int n = 0;
    auto emit = [&](int k, int l) { const int reps = ((REPMASK >> k) & 1) ? 2 : 1;
      for (int r = 0; r < reps; ++r) p.prog[n++] = (unsigned char)(k | (l << 4) | ((nosync[k] && r + 1 == reps) ? 0 : 0x80)); };
    emit(8, 0);
    for (int l = 0; l < DEPTH; ++l) for (int k = 0; k < 8; ++k) { if (k == 2) emit(12, l); emit(k, l); if (k == 3) emit(11, l); }
#ifdef NOPSYNCS
    for (int i = 0; i < NOPSYNCS; ++i) p.prog[n++] = (unsigned char)(10 | 0x80);
#endif
    emit(9, 0);
    while (n < 64) p.prog[n++] = 0xFF;
  }
  void* args[] = {&p};
  hipError_t e = hipLaunchCooperativeKernel((void*)fwd_megakernel, dim3(grid_blocks), dim3(512), args, LDS_BYTES, stream);
  if (e != hipSuccess) fprintf(stderr, "cooperative launch failed: %s\n", hipGetErrorString(e));
}
```

```cpp
#include <hip/hip_runtime.h>
#include <hip/hip_cooperative_groups.h>
#include <cstdio>
#include <cstdint>
namespace cg = cooperative_groups;

#define LAS __attribute__((address_space(3)))
typedef unsigned short u16;
typedef short bf16x8 __attribute__((ext_vector_type(8)));
typedef float f32x4 __attribute__((ext_vector_type(4)));
typedef unsigned u32x4 __attribute__((ext_vector_type(4)));
typedef unsigned u32x2 __attribute__((ext_vector_type(2)));

constexpr int DM = 1024, NTOK = 24576, NPROMPT = 8192, DEPTH = 4, NG1 = 8192, DIN = 8192;
constexpr int LDS_BYTES = 144 * 1024;
constexpr size_t MiB = 1u << 20;
constexpr size_t WS_MOD = 1 * MiB;
constexpr size_t WS_LBS = WS_MOD + 256 * 1024;
constexpr size_t WS_DFTP = 2 * MiB;
constexpr size_t WS_WIN = 4 * MiB;
constexpr size_t WS_WPA = 72 * MiB;
constexpr size_t WS_WPB = 80 * MiB;
constexpr size_t WS_WO = 84 * MiB;
constexpr size_t WS_DFTS = 92 * MiB;
constexpr size_t WS_H = 156 * MiB;
constexpr size_t WS_Q = 204 * MiB;
constexpr size_t WS_LF = 252 * MiB;
constexpr size_t WS_LB = 300 * MiB;
constexpr size_t WS_V = 348 * MiB;
constexpr size_t WS_ZA = 396 * MiB;
constexpr size_t WS_ZB = 444 * MiB;
constexpr size_t WS_GA = 468 * MiB;
constexpr size_t WS_GB = 516 * MiB;
constexpr size_t WS_UT = 564 * MiB;
constexpr size_t WS_YAB = 612 * MiB;
constexpr size_t WS_OF = 684 * MiB;
constexpr size_t WS_OB = 780 * MiB;
constexpr size_t WS_SLOC = 876 * MiB;
constexpr size_t WS_LSEG = 1 * MiB + 512 * 1024;
constexpr size_t WS_END = 889 * MiB;
constexpr size_t WS_MERGED = WS_OB;
constexpr size_t UT_SAMPLE_OFF = (size_t)32 * 512 * 512;

struct P {
  const float *x_prompt, *x_sample, *state, *c, *c_ctx, *norm_w, *w_ada, *b_ada, *w_in, *lb_raw, *gnorm_w, *w_pa, *w_pb, *w_o, *final_w;
  float* out; unsigned char* ws;
  unsigned char prog[64];
};

typedef float f32x2v __attribute__((ext_vector_type(2)));
typedef __bf16 bf16x2v __attribute__((ext_vector_type(2)));
__device__ __forceinline__ unsigned pk2(float lo, float hi) { const f32x2v v = {lo, hi}; const bf16x2v b = __builtin_convertvector(v, bf16x2v); return __builtin_bit_cast(unsigned, b); }
__device__ __forceinline__ u16 f2bf(float f) { unsigned u = __float_as_uint(f); u += 0x7FFFu + ((u >> 16) & 1u); return (u16)(u >> 16); }
__device__ __forceinline__ float bf2f(unsigned b) { return __uint_as_float(b << 16); }
__device__ __forceinline__ float bflo(unsigned w) { return __uint_as_float(w << 16); }
__device__ __forceinline__ float bfhi(unsigned w) { return __uint_as_float(w & 0xFFFF0000u); }
__device__ __forceinline__ float h2f(unsigned short h) { return (float)__builtin_bit_cast(_Float16, h); }
__device__ __forceinline__ unsigned short f2h(float f) { return __builtin_bit_cast(unsigned short, (_Float16)f); }
__device__ __forceinline__ float siluf(float x) { return x * __builtin_amdgcn_rcpf(1.f + __expf(-x)); }
__device__ __forceinline__ float sigmf(float x) { return __builtin_amdgcn_rcpf(1.f + __expf(-x)); }
__device__ __forceinline__ float wave_sum(float v) {
#pragma unroll
  for (int o = 1; o < 64; o <<= 1) v += __shfl_xor(v, o);
  return v;
}

namespace pg8 {
constexpr int BM = 256, BK = 64, HALF = 128, HTB = HALF * BK * 2, STAGE_BYTES = 8 * HTB, NXCD = 8, WGM = 4;
__host__ __device__ __forceinline__ int lds_byte(int r, int c) { const int st = (r >> 4) * 2 + (c >> 5), rr = r & 15, cc = c & 31, ob = rr * 64 + cc * 2; return st * 1024 + (ob ^ (((ob >> 9) & 1) << 5)); }
__host__ __device__ __forceinline__ void stage_rc(int b, int& R, int& C) { const int st = b / 1024, sb = b % 1024, swz = sb ^ (((sb >> 9) & 1) << 5); R = (st >> 1) * 16 + swz / 64; C = (st & 1) * 32 + (swz % 64) / 2; }
__host__ __device__ __forceinline__ int perm32(int rho) { const int n = rho >> 4, i = rho & 15; return 8 * (i >> 2) + 4 * n + (i & 3); }
struct Unit { int pm, pn; };
struct Gemm { const u16* A; const u16* Bt; int M, N, K; };
struct StaticOrder {
  int nM, nN, nwg, G, c;
  __device__ void init(int M, int N, int G_, int c_) { nM = M / BM; nN = N / BM; nwg = nM * nN; G = G_; c = c_; }
  __device__ bool next(int i, Unit& u) const {
    const long L = (long)i * G + c; if (c < 0 || L >= nwg) return false;
    int wgid = (int)L; { const int q = nwg / NXCD, r = nwg % NXCD, xcd = wgid % NXCD, off = wgid / NXCD; wgid = (xcd < r ? xcd * (q + 1) : r * (q + 1) + (xcd - r) * q) + off; }
    const int nig = WGM * nN, gid = wgid / nig, fm = gid * WGM, gsz = (nM - fm) < WGM ? (nM - fm) : WGM;
    u.pm = fm + ((wgid % nig) % gsz); u.pn = (wgid % nig) / gsz; return true;
  }
};
template <class Epi>
__device__ __forceinline__ void gemm_phase(LAS unsigned char* lds, const Gemm g, const StaticOrder& S, const Epi& E, const int tid) {
  const int wid = __builtin_amdgcn_readfirstlane(tid >> 6), lane = tid & 63, wr = wid >> 2, wc = wid & 3, fr = lane & 15, fq = lane >> 4;
  const int K = g.K, nt = K / BK;
  unsigned voffA[2], voffB[2];
#pragma unroll
  for (int i = 0; i < 2; ++i) { int R, C; stage_rc(tid * 16 + i * 8192, R, C); const int Rb = E.perm ? ((R & ~31) + perm32(R & 31)) : R;
    voffA[i] = (unsigned)(R * K + C) * 2u; voffB[i] = (unsigned)(Rb * K + C) * 2u; }
  const size_t kstep = (size_t)(BK * 2);
  const size_t hstep = (size_t)HALF * K * 2;
  const size_t tstep = 2 * hstep;
  const unsigned ldsw = (unsigned)wid * 1024u;
  const int aoff = lds_byte(wr * 64 + fr, fq * 8), boff = lds_byte(wc * 32 + fr, fq * 8);
#define PG8_SA(b, h) (((b) * 2 + (h)) * HTB)
#define PG8_SB(b, h) ((4 + (b) * 2 + (h)) * HTB)
#define PG8_STAGE(bufoff, gbase, voff) do { _Pragma("unroll") for (int _i = 0; _i < 2; ++_i) \
    __builtin_amdgcn_global_load_lds((const unsigned*)((const char*)(gbase) + (voff)[_i]), (LAS unsigned*)(lds + (bufoff) + ldsw + _i * 8192), 16, 0, 0); } while (0)
#define PG8_LDA(dst, b, h) do { _Pragma("unroll") for (int m = 0; m < 4; ++m) _Pragma("unroll") for (int k = 0; k < 2; ++k) dst[m][k] = *(const LAS bf16x8*)(lds + PG8_SA(b, h) + aoff + m * 2048 + k * 1024); } while (0)
#define PG8_LDB(dst, b, h) do { _Pragma("unroll") for (int n = 0; n < 2; ++n) _Pragma("unroll") for (int k = 0; k < 2; ++k) dst[n][k] = *(const LAS bf16x8*)(lds + PG8_SB(b, h) + boff + n * 2048 + k * 1024); } while (0)
#define PG8_MMA(ai, bj, At, Bt) do { __builtin_amdgcn_s_setprio(1); _Pragma("unroll") for (int m = 0; m < 4; ++m) _Pragma("unroll") for (int n = 0; n < 2; ++n) _Pragma("unroll") for (int k = 0; k < 2; ++k) \
    acc[ai][bj][m][n] = __builtin_amdgcn_mfma_f32_16x16x32_bf16(Bt[n][k], At[m][k], acc[ai][bj][m][n], 0, 0, 0); __builtin_amdgcn_s_setprio(0); } while (0)
#define PG8_WAIT_V(n) asm volatile("s_waitcnt vmcnt(" #n ")" ::: "memory")
#define PG8_WAIT_L(n) asm volatile("s_waitcnt lgkmcnt(" #n ")" ::: "memory")
#define PG8_BAR __builtin_amdgcn_s_barrier()
#define PG8_SCHED __builtin_amdgcn_sched_barrier(0)
  Unit cur, nxt; int ui = 0;
  if (!S.next(0, cur)) return;
  f32x4 acc[2][2][4][2];
#pragma unroll
  for (int a = 0; a < 2; ++a)
#pragma unroll
    for (int b = 0; b < 2; ++b)
#pragma unroll
      for (int m = 0; m < 4; ++m)
#pragma unroll
        for (int n = 0; n < 2; ++n) acc[a][b][m][n] = (f32x4){0.f, 0.f, 0.f, 0.f};
  bf16x8 At[4][2], B0[2][2], B1[2][2];
  const char* cA = (const char*)g.A + (size_t)cur.pm * tstep; const char* cB = (const char*)g.Bt + (size_t)cur.pn * tstep;
  PG8_STAGE(PG8_SB(0, 0), cB, voffB); PG8_STAGE(PG8_SA(0, 0), cA, voffA); PG8_STAGE(PG8_SB(0, 1), cB + hstep, voffB); PG8_STAGE(PG8_SA(0, 1), cA + hstep, voffA);
  if (wr == 1) PG8_BAR;
  PG8_WAIT_V(4); PG8_BAR;
  PG8_STAGE(PG8_SB(1, 0), cB + kstep, voffB); PG8_STAGE(PG8_SA(1, 0), cA + kstep, voffA); PG8_STAGE(PG8_SB(1, 1), cB + hstep + kstep, voffB);
  PG8_WAIT_V(6); PG8_BAR;
  for (;;) {
    const bool has_next = S.next(ui + 1, nxt);
    const char* nA = has_next ? (const char*)g.A + (size_t)nxt.pm * tstep : cA; const char* nB = has_next ? (const char*)g.Bt + (size_t)nxt.pn * tstep : cB;
    for (int t = 0; t < nt; t += 2) {
      const bool last = (t == nt - 2);
      if (E.type == 2 && t == 16) E.hook(acc, cur, wr, wc, fr, fq);
      const char* a1 = cA + (size_t)(t + 1) * kstep;
      const char* a2 = last ? nA : cA + (size_t)(t + 2) * kstep; const char* b2 = last ? nB : cB + (size_t)(t + 2) * kstep;
      const char* a3 = a2 + kstep; const char* b3 = b2 + kstep;
      PG8_LDB(B0, 0, 0); PG8_SCHED; PG8_LDA(At, 0, 0); PG8_STAGE(PG8_SA(1, 1), a1 + hstep, voffA);
      PG8_WAIT_L(8); PG8_BAR; PG8_WAIT_L(0); PG8_MMA(0, 0, At, B0); PG8_BAR; PG8_SCHED;
      PG8_LDB(B1, 0, 1); PG8_STAGE(PG8_SB(0, 0), b2, voffB);
      PG8_BAR; PG8_WAIT_L(0); PG8_MMA(0, 1, At, B1); PG8_BAR;
      PG8_LDA(At, 0, 1); PG8_STAGE(PG8_SA(0, 0), a2, voffA);
      PG8_BAR; PG8_WAIT_L(0); PG8_MMA(1, 0, At, B0); PG8_BAR; PG8_SCHED;
      PG8_STAGE(PG8_SB(0, 1), b2 + hstep, voffB);
      PG8_WAIT_V(6); PG8_BAR; PG8_MMA(1, 1, At, B1); PG8_BAR;
      PG8_LDB(B0, 1, 0); PG8_SCHED; PG8_LDA(At, 1, 0); PG8_STAGE(PG8_SA(0, 1), a2 + hstep, voffA);
      PG8_WAIT_L(8); PG8_BAR; PG8_WAIT_L(0); PG8_MMA(0, 0, At, B0); PG8_BAR; PG8_SCHED;
      PG8_LDB(B1, 1, 1); PG8_STAGE(PG8_SB(1, 0), b3, voffB);
      PG8_BAR; PG8_WAIT_L(0); PG8_MMA(0, 1, At, B1); PG8_BAR;
      PG8_LDA(At, 1, 1); PG8_STAGE(PG8_SA(1, 0), a3, voffA);
      PG8_BAR; PG8_WAIT_L(0); PG8_MMA(1, 0, At, B0); PG8_BAR; PG8_SCHED;
      PG8_STAGE(PG8_SB(1, 1), b3 + hstep, voffB);
      PG8_WAIT_V(6); PG8_BAR; PG8_MMA(1, 1, At, B1); PG8_BAR;
    }
    E(acc, cur, wr, wc, fr, fq);
    if (!has_next) break;
#pragma unroll
    for (int a = 0; a < 2; ++a)
#pragma unroll
      for (int b = 0; b < 2; ++b)
#pragma unroll
        for (int m = 0; m < 4; ++m)
#pragma unroll
          for (int n = 0; n < 2; ++n) acc[a][b][m][n] = (f32x4){0.f, 0.f, 0.f, 0.f};
    cur = nxt; cA = nA; cB = nB; ++ui;
  }
  PG8_WAIT_V(0);
  if (wr == 0) PG8_BAR;
  PG8_BAR;
#undef PG8_SA
#undef PG8_SB
#undef PG8_STAGE
#undef PG8_LDA
#undef PG8_LDB
#undef PG8_MMA
#undef PG8_WAIT_V
#undef PG8_WAIT_L
#undef PG8_BAR
#undef PG8_SCHED
}
}
using pg8::Unit; using pg8::Gemm; using pg8::StaticOrder;
typedef f32x4 Acc[2][2][4][2];

struct EpiG1 {
  static constexpr bool PERM = true;
  unsigned char* ws; const float* lbs;
  __device__ __forceinline__ void operator()(const Acc& acc, const Unit& u, int wr, int wc, int fr, int fq) const {
    const int pn = u.pn, row0 = u.pm * 256 + wr * 64 + fr;
    if (pn >= 20 && pn < 22) {
      u16* UT = (u16*)(ws + WS_UT);
#pragma unroll
      for (int ai = 0; ai < 2; ++ai)
#pragma unroll
        for (int m = 0; m < 4; ++m) {
          const int r = row0 + ai * 128 + m * 16;
          size_t base; size_t chs, pstr;
          if (r < NPROMPT) { const int bp = r >> 8, l = r & 255; base = (size_t)bp * 512 * 512 + l; chs = 512; pstr = 256; }
          else { const int rr = r - NPROMPT, b = rr >> 12, l = rr & 4095; base = UT_SAMPLE_OFF + (size_t)b * 512 * 8192 + l; chs = 8192; pstr = 4096; }
#pragma unroll
          for (int bj = 0; bj < 2; ++bj) {
            const int j0 = (pn - 20) * 256 + bj * 128 + wc * 32 + 8 * fq;
#pragma unroll
            for (int n = 0; n < 2; ++n)
#pragma unroll
              for (int e = 0; e < 4; e += 2) { const unsigned pr = pk2(acc[ai][bj][m][n][e], acc[ai][bj][m][n][e + 1]);
#pragma unroll
                for (int h = 0; h < 2; ++h) { const int j = j0 + 4 * n + e + h, g = j >> 7, q = j & 127, part = q > 64 ? 1 : 0, mm = part ? q - 64 : q;
                  UT[base + part * pstr + (size_t)(g * 128 + mm) * chs] = h ? (u16)(pr >> 16) : (u16)(pr & 0xFFFFu); } }
          }
        }
      return;
    }
    int act, ld = 1024, colt; size_t off;
    if (pn < 4) { act = 1; off = WS_Q; colt = pn * 256; }
    else if (pn < 8) { act = 3; off = WS_LF; colt = (pn - 4) * 256; }
    else if (pn < 12) { act = 4; off = WS_LB; colt = (pn - 8) * 256; }
    else if (pn < 16) { act = 0; off = WS_V; colt = (pn - 12) * 256; }
    else if (pn < 20) { act = 1; off = WS_ZA; colt = (pn - 16) * 256; }
    else if (pn < 24) { act = 1; off = WS_ZB; colt = (pn - 22) * 256; ld = 512; }
    else if (pn < 28) { act = 2; off = WS_GA; colt = (pn - 24) * 256; }
    else { act = 2; off = WS_GB; colt = (pn - 28) * 256; }
    u16* dst = (u16*)(ws + off);
    const int col0 = colt + wc * 32 + 8 * fq;
    f32x4 lbv[2][2];
    if (act >= 3) { const float* lb = lbs + (act == 4 ? 1024 : 0) + col0;
#pragma unroll
      for (int bj = 0; bj < 2; ++bj) { lbv[bj][0] = *(const f32x4*)(lb + bj * 128); lbv[bj][1] = *(const f32x4*)(lb + bj * 128 + 4); } }
#pragma unroll
    for (int ai = 0; ai < 2; ++ai)
#pragma unroll
      for (int m = 0; m < 4; ++m) {
        u16* rowp = dst + (size_t)(row0 + ai * 128 + m * 16) * ld + col0;
#pragma unroll
        for (int bj = 0; bj < 2; ++bj) {
          float v[8];
#pragma unroll
          for (int e = 0; e < 8; ++e) v[e] = acc[ai][bj][m][e >> 2][e & 3];
          u32x4 o;
          if (act >= 3) {
            unsigned short hv[8];
#pragma unroll
            for (int e = 0; e < 8; ++e) { const float oml = 1.f - lbv[bj][e >> 2][e & 3]; const float kk = oml * __builtin_amdgcn_rcpf(1.f + __expf(v[e])); hv[e] = f2h(fmaxf(__log2f(1.f - kk), -57.f)); }
            o[0] = hv[0] | ((unsigned)hv[1] << 16); o[1] = hv[2] | ((unsigned)hv[3] << 16); o[2] = hv[4] | ((unsigned)hv[5] << 16); o[3] = hv[6] | ((unsigned)hv[7] << 16);
          } else {
            if (act == 1) {
#pragma unroll
              for (int e = 0; e < 8; ++e) v[e] = siluf(v[e]);
            } else if (act == 2) {
#pragma unroll
              for (int e = 0; e < 8; ++e) v[e] = sigmf(v[e]);
            }
            o[0] = pk2(v[0], v[1]); o[1] = pk2(v[2], v[3]); o[2] = pk2(v[4], v[5]); o[3] = pk2(v[6], v[7]);
          }
          *(u32x4*)(rowp + bj * 128) = o;
        }
      }
  }
};
struct EpiDFT {
  static constexpr bool PERM = true;
  unsigned char* ws; int rowbase, lshift; float scale;
  __device__ __forceinline__ void operator()(const Acc& acc, const Unit& u, int wr, int wc, int fr, int fq) const {
    const u16* ZB = (const u16*)(ws + WS_ZB); u16* YB = (u16*)(ws + WS_YAB);
    const int k0 = u.pm * 256 + wr * 64 + fr;
    const int n0 = u.pn * 256 + wc * 32 + 8 * fq, b = n0 >> 9, ch0 = n0 & 511;
    const size_t R0 = (size_t)rowbase + ((size_t)b << lshift) + k0;
    const u16* zb = ZB + R0 * 512 + ch0; u16* yb = YB + R0 * 1536 + 1024 + ch0;
#pragma unroll
    for (int ai = 0; ai < 2; ++ai) {
      u32x4 z[4][2];
#pragma unroll
      for (int m = 0; m < 4; ++m)
#pragma unroll
        for (int bj = 0; bj < 2; ++bj) z[m][bj] = *(const u32x4*)(zb + (ai * 128 + m * 16) * 512 + bj * 128);
#pragma unroll
      for (int m = 0; m < 4; ++m)
#pragma unroll
        for (int bj = 0; bj < 2; ++bj) {
          const u32x4 zz = z[m][bj]; u32x4 o;
          o[0] = pk2(acc[ai][bj][m][0][0] * scale * bflo(zz[0]), acc[ai][bj][m][0][1] * scale * bfhi(zz[0]));
          o[1] = pk2(acc[ai][bj][m][0][2] * scale * bflo(zz[1]), acc[ai][bj][m][0][3] * scale * bfhi(zz[1]));
          o[2] = pk2(acc[ai][bj][m][1][0] * scale * bflo(zz[2]), acc[ai][bj][m][1][1] * scale * bfhi(zz[2]));
          o[3] = pk2(acc[ai][bj][m][1][2] * scale * bflo(zz[3]), acc[ai][bj][m][1][3] * scale * bfhi(zz[3]));
          *(u32x4*)(yb + (ai * 128 + m * 16) * 1536 + bj * 128) = o;
        }
      __builtin_amdgcn_sched_barrier(0);
    }
  }
};
struct EpiG2 {
  static constexpr bool PERM = false;
  unsigned char* ws;
  __device__ __forceinline__ void hook(Acc& acc, const Unit& u, int wr, int wc, int fr, int fq) const {
    const u16* GA = (const u16*)(ws + WS_GA); const u16* GB = (const u16*)(ws + WS_GB);
    const int row0 = u.pm * 256 + wr * 64 + fr, col0 = u.pn * 256 + wc * 32 + 4 * fq;
#pragma unroll
    for (int ai = 0; ai < 2; ++ai) {
      u32x2 ga[4][2][2], gb[4][2][2];
#pragma unroll
      for (int m = 0; m < 4; ++m)
#pragma unroll
        for (int bj = 0; bj < 2; ++bj)
#pragma unroll
          for (int n = 0; n < 2; ++n) { const size_t idx = (size_t)(row0 + ai * 128 + m * 16) * 1024 + col0 + bj * 128 + n * 16;
            ga[m][bj][n] = *(const u32x2*)(GA + idx); gb[m][bj][n] = *(const u32x2*)(GB + idx); }
#pragma unroll
      for (int m = 0; m < 4; ++m)
#pragma unroll
        for (int bj = 0; bj < 2; ++bj)
#pragma unroll
          for (int n = 0; n < 2; ++n) { const u32x2 a = ga[m][bj][n], b = gb[m][bj][n]; f32x4& v = acc[ai][bj][m][n];
            v[0] *= bflo(a[0]) * __builtin_amdgcn_rcpf(fmaxf(bflo(b[0]), 1e-30f)); v[1] *= bfhi(a[0]) * __builtin_amdgcn_rcpf(fmaxf(bfhi(b[0]), 1e-30f));
            v[2] *= bflo(a[1]) * __builtin_amdgcn_rcpf(fmaxf(bflo(b[1]), 1e-30f)); v[3] *= bfhi(a[1]) * __builtin_amdgcn_rcpf(fmaxf(bfhi(b[1]), 1e-30f)); }
      __builtin_amdgcn_sched_barrier(0);
    }
  }
  __device__ __forceinline__ void operator()(const Acc& acc, const Unit& u, int wr, int wc, int fr, int fq) const {
    const u16* GB = (const u16*)(ws + WS_GB); u16* MG = (u16*)(ws + WS_MERGED);
    const int row0 = u.pm * 256 + wr * 64 + fr, col0 = u.pn * 256 + wc * 32 + 4 * fq;
#pragma unroll
    for (int ai = 0; ai < 2; ++ai) {
      u32x2 gb[4][2][2];
#pragma unroll
      for (int m = 0; m < 4; ++m)
#pragma unroll
        for (int bj = 0; bj < 2; ++bj)
#pragma unroll
          for (int n = 0; n < 2; ++n) gb[m][bj][n] = *(const u32x2*)(GB + (size_t)(row0 + ai * 128 + m * 16) * 1024 + col0 + bj * 128 + n * 16);
#pragma unroll
      for (int m = 0; m < 4; ++m)
#pragma unroll
        for (int bj = 0; bj < 2; ++bj)
#pragma unroll
          for (int n = 0; n < 2; ++n) { const u32x2 b = gb[m][bj][n]; const f32x4 v = acc[ai][bj][m][n];
            u32x2 o; o[0] = pk2(v[0] * bflo(b[0]), v[1] * bfhi(b[0])); o[1] = pk2(v[2] * bflo(b[1]), v[3] * bfhi(b[1]));
            *(u32x2*)(MG + (size_t)(row0 + ai * 128 + m * 16) * 1024 + col0 + bj * 128 + n * 16) = o; }
      __builtin_amdgcn_sched_barrier(0);
    }
  }
};
struct EpiG3 {
  static constexpr bool PERM = false;
  float* x; const float* modl;
  __device__ __forceinline__ void operator()(const Acc& acc, const Unit& u, int wr, int wc, int fr, int fq) const {
    const int j = u.pm < 32 ? 0 : 1 + ((u.pm - 32) >> 4);
    const float* gt = modl + j * 3072 + 2048;
    const int row0 = u.pm * 256 + wr * 64 + fr, col0 = u.pn * 256 + wc * 32 + 4 * fq;
    f32x4 gv[2][2];
#pragma unroll
    for (int bj = 0; bj < 2; ++bj)
#pragma unroll
      for (int n = 0; n < 2; ++n) gv[bj][n] = *(const f32x4*)(gt + col0 + bj * 128 + n * 16);
#pragma unroll
    for (int ai = 0; ai < 2; ++ai)
#pragma unroll
      for (int mp = 0; mp < 2; ++mp) {
        f32x4 xv[2][2][2];
#pragma unroll
        for (int mi = 0; mi < 2; ++mi)
#pragma unroll
          for (int bj = 0; bj < 2; ++bj)
#pragma unroll
            for (int n = 0; n < 2; ++n) xv[mi][bj][n] = *(const f32x4*)(x + (size_t)(row0 + ai * 128 + (2 * mp + mi) * 16) * 1024 + col0 + bj * 128 + n * 16);
#pragma unroll
        for (int mi = 0; mi < 2; ++mi)
#pragma unroll
          for (int bj = 0; bj < 2; ++bj)
#pragma unroll
            for (int n = 0; n < 2; ++n) *(f32x4*)(x + (size_t)(row0 + ai * 128 + (2 * mp + mi) * 16) * 1024 + col0 + bj * 128 + n * 16) = xv[mi][bj][n] + gv[bj][n] * acc[ai][bj][2 * mp + mi][n];
        __builtin_amdgcn_sched_barrier(0);
      }
  }
};

__device__ __forceinline__ void p0_prologue(const P& p, unsigned char* shm, const int tid) {
  const int bid = blockIdx.x, G = gridDim.x;
  float* fs = (float*)shm;
  for (int i = bid * 512 + tid; i < 2048; i += G * 512) {
    float r[4], mx = -1e30f;
    for (int l = 0; l < 4; ++l) { r[l] = p.lb_raw[l * 2048 + i]; mx = fmaxf(mx, r[l]); }
    float s = 0.f; for (int l = 0; l < 4; ++l) { r[l] = expf(r[l] - mx); s += r[l]; }
    float cs = 0.f; float* lbs = (float*)(p.ws + WS_LBS);
    for (int l = 0; l < 4; ++l) { if (l > 0) cs += r[l] / s; lbs[l * 2048 + i] = cs; }
  }
  for (int it = bid; it < 96; it += G) {
    const int l = it / 24, n0 = (it % 24) * 128;
    for (int i = tid; i < 5120; i += 512) { const int j = i >> 10, k = i & 1023; const float cv = j == 0 ? p.c_ctx[k] : p.c[(j - 1) * 1024 + k]; fs[i] = cv / (1.f + expf(-cv)); }
    __syncthreads();
    const int col = tid & 127, kq = tid >> 7;
    float a[5] = {0.f, 0.f, 0.f, 0.f, 0.f};
    const float* w = p.w_ada + ((size_t)l * 1024 + kq * 256) * 3072 + n0 + col;
    for (int k = 0; k < 256; k += 32) {
      float wv[32];
#pragma unroll
      for (int u = 0; u < 32; ++u) wv[u] = w[(size_t)(k + u) * 3072];
#pragma unroll
      for (int u = 0; u < 32; ++u)
#pragma unroll
        for (int j = 0; j < 5; ++j) a[j] += fs[j * 1024 + kq * 256 + k + u] * wv[u];
    }
    __syncthreads();
#pragma unroll
    for (int j = 0; j < 5; ++j) fs[5120 + (kq * 5 + j) * 128 + col] = a[j];
    __syncthreads();
    if (tid < 128) {
      float* modv = (float*)(p.ws + WS_MOD);
#pragma unroll
      for (int j = 0; j < 5; ++j) { const float s = fs[5120 + (0 * 5 + j) * 128 + tid] + fs[5120 + (1 * 5 + j) * 128 + tid] + fs[5120 + (2 * 5 + j) * 128 + tid] + fs[5120 + (3 * 5 + j) * 128 + tid];
        modv[((size_t)l * 5 + j) * 3072 + n0 + tid] = s + p.b_ada[l * 3072 + n0 + tid]; }
    }
    __syncthreads();
  }
  for (int it = bid; it < 256; it += G) {
    const int l = it >> 6, g = (it >> 4) & 3, k0 = (it & 15) * 64;
    for (int i = tid; i < 64 * 32; i += 512) { const int kk = i >> 5, c4 = (i & 31) * 4;
      const f32x4 v = *(const f32x4*)(p.w_in + ((size_t)l * 1024 + k0 + kk) * DIN + 5120 + g * 128 + c4);
      fs[(c4 + 0) * 68 + kk] = v[0]; fs[(c4 + 1) * 68 + kk] = v[1]; fs[(c4 + 2) * 68 + kk] = v[2]; fs[(c4 + 3) * 68 + kk] = v[3]; }
    __syncthreads();
    const int q = tid & 127, kq = tid >> 7, iscos = q <= 64, m = iscos ? q : q - 64;
    float sm, cm; sincospif((float)m / 64.f, &sm, &cm);
    float cr = 1.f, sr = 0.f, ac[16];
#pragma unroll
    for (int i = 0; i < 16; ++i) ac[i] = 0.f;
    for (int c = 0; c < 128; ++c) {
      const float* wrow = fs + c * 68 + kq * 16;
      const float tw = iscos ? cr : -sr;
#pragma unroll
      for (int i4 = 0; i4 < 4; ++i4) { const f32x4 wv = *(const f32x4*)(wrow + i4 * 4);
#pragma unroll
        for (int e = 0; e < 4; ++e) ac[i4 * 4 + e] += wv[e] * tw; }
      const float c2 = cr * cm - sr * sm, s2 = sr * cm + cr * sm; cr = c2; sr = s2;
    }
    u16* WIN = (u16*)(p.ws + WS_WIN) + (size_t)l * NG1 * 1024;
    u32x4 o0, o1;
    o0[0] = pk2(ac[0], ac[1]); o0[1] = pk2(ac[2], ac[3]); o0[2] = pk2(ac[4], ac[5]); o0[3] = pk2(ac[6], ac[7]);
    o1[0] = pk2(ac[8], ac[9]); o1[1] = pk2(ac[10], ac[11]); o1[2] = pk2(ac[12], ac[13]); o1[3] = pk2(ac[14], ac[15]);
    u16* dc = WIN + (size_t)(5120 + g * 128 + q) * 1024 + k0 + kq * 16;
    *(u32x4*)dc = o0; *(u32x4*)(dc + 8) = o1;
    __syncthreads();
  }
  {
    constexpr int I_IN = 16 * 120, I_PA = 16 * 16, I_PB = 8 * 16, I_O = 16 * 16, I_L = I_IN + I_PA + I_PB + I_O;
    for (int it0 = bid; it0 < 4 * I_L; it0 += 4 * G) {
#pragma unroll
      for (int q = 0; q < 4; ++q) {
        const int it = it0 + q * G; if (it >= 4 * I_L) break;
        const int l = it / I_L; int r = it % I_L;
        const float* W; int Nsrc, kb, nsrc0;
        if (r < I_IN) { kb = r / 120; const int nb = r % 120; nsrc0 = nb * 64 + (nb * 64 >= 5120 ? 512 : 0); W = p.w_in + (size_t)l * 1024 * DIN; Nsrc = DIN; }
        else if ((r -= I_IN) < I_PA) { kb = r / 16; nsrc0 = (r % 16) * 64; W = p.w_pa + (size_t)l * 1024 * 1024; Nsrc = 1024; }
        else if ((r -= I_PA) < I_PB) { kb = r / 16; nsrc0 = (r % 16) * 64; W = p.w_pb + (size_t)l * 512 * 1024; Nsrc = 1024; }
        else { r -= I_PB; kb = r / 16; nsrc0 = (r % 16) * 64; W = p.w_o + (size_t)l * 1024 * 1024; Nsrc = 1024; }
        const int k0 = kb * 64;
#pragma unroll
        for (int ps = 0; ps < 8; ++ps) { const int kk = ps * 8 + (tid >> 6), nn = tid & 63; fs[q * 4160 + kk * 65 + nn] = W[(size_t)(k0 + kk) * Nsrc + nsrc0 + nn]; }
      }
      __syncthreads();
#pragma unroll
      for (int q = 0; q < 4; ++q) {
        const int it = it0 + q * G; if (it >= 4 * I_L) break;
        const int l = it / I_L; int r = it % I_L;
        u16* WT; int Kd, kb, ndst0;
        if (r < I_IN) { kb = r / 120; const int nb = r % 120; ndst0 = nb * 64; if (ndst0 >= 5120) ndst0 += 512; WT = (u16*)(p.ws + WS_WIN) + (size_t)l * NG1 * 1024; Kd = 1024; }
        else if ((r -= I_IN) < I_PA) { kb = r / 16; ndst0 = (r % 16) * 64; WT = (u16*)(p.ws + WS_WPA) + (size_t)l * 1024 * 1536; Kd = 1536; }
        else if ((r -= I_PA) < I_PB) { kb = r / 16; ndst0 = (r % 16) * 64; WT = (u16*)(p.ws + WS_WPA) + (size_t)l * 1024 * 1536 + 1024; Kd = 1536; }
        else { r -= I_PB; kb = r / 16; ndst0 = (r % 16) * 64; WT = (u16*)(p.ws + WS_WO) + (size_t)l * 1024 * 1024; Kd = 1024; }
        const int k0 = kb * 64;
        const int nn = tid >> 3, kc = tid & 7; const float* sp = fs + q * 4160 + (8 * kc) * 65 + nn;
        u32x4 o; o[0] = pk2(sp[0], sp[65]); o[1] = pk2(sp[2 * 65], sp[3 * 65]); o[2] = pk2(sp[4 * 65], sp[5 * 65]); o[3] = pk2(sp[6 * 65], sp[7 * 65]);
        *(u32x4*)(WT + (size_t)(ndst0 + nn) * Kd + k0 + 8 * kc) = o;
      }
      __syncthreads();
    }
  }
  {
    __syncthreads();
    for (int r = tid; r < 4096; r += 512) { float sv, cv; sincospif((float)r * (1.f / 2048.f), &sv, &cv); fs[r] = cv; fs[4096 + r] = sv; }
    __syncthreads();
    u16* DS = (u16*)(p.ws + WS_DFTS);
    for (size_t i = (size_t)bid * 512 + tid; i < (size_t)4096 * 512; i += (size_t)G * 512) {
      const int k = (int)(i >> 9), j0 = (int)(i & 511) * 8; const int part = j0 >> 11, jj = j0 & 2047;
      const float* tb = fs + part * 4096;
      float v[8];
#pragma unroll
      for (int e = 0; e < 8; ++e) v[e] = tb[(k * (jj + e)) & 4095];
      if (part == 1 && jj == 0) v[0] = (k & 1) ? -1.f : 1.f;
      u32x4 o; o[0] = pk2(v[0], v[1]); o[1] = pk2(v[2], v[3]); o[2] = pk2(v[4], v[5]); o[3] = pk2(v[6], v[7]);
      *(u32x4*)(DS + (size_t)k * 4096 + j0) = o;
    }
    u16* DP = (u16*)(p.ws + WS_DFTP);
    for (int i = bid * 512 + tid; i < 256 * 64; i += G * 512) {
      const int k = i >> 6, j0 = (i & 63) * 8; const int part = j0 >> 8, jj = j0 & 255;
      const float* tb = fs + part * 4096;
      float v[8];
#pragma unroll
      for (int e = 0; e < 8; ++e) v[e] = tb[((k * (jj + e)) & 255) * 16];
      u32x4 o; o[0] = pk2(v[0], v[1]); o[1] = pk2(v[2], v[3]); o[2] = pk2(v[4], v[5]); o[3] = pk2(v[6], v[7]);
      *(u32x4*)(DP + (size_t)k * 512 + j0) = o;
    }
  }
}

__device__ __forceinline__ void phase_fold(const P& p, const int tid) {
  const u16* UT = (const u16*)(p.ws + WS_UT) + UT_SAMPLE_OFF; u16* UF = (u16*)(p.ws + WS_H);
  for (int it = blockIdx.x * 512 + tid; it < 2048 * 512; it += gridDim.x * 512) {
    const int n = it >> 9, c = it & 511, part = c >> 8, cc = c & 255;
    const int ch = n & 511, b = n >> 9, g = ch >> 7, m = ch & 127, msrc = m <= 64 ? m : 128 - m;
    const u16* rowc = UT + (size_t)(b * 512 + g * 128 + msrc) * 8192;
    const bool zero = part && (m == 0 || m == 64); const float sgn = (part && m > 64) ? -1.f : 1.f;
    const u16* base = rowc + part * 4096;
    const u32x4 f = *(const u32x4*)(base + 8 * cc), g8 = *(const u32x4*)(base + 4096 - 8 * cc - 8);
    float fw[8], bw[8], gv[8];
#pragma unroll
    for (int e = 0; e < 4; ++e) { fw[2 * e] = bflo(f[e]); fw[2 * e + 1] = bfhi(f[e]); gv[2 * e] = bflo(g8[e]); gv[2 * e + 1] = bfhi(g8[e]); }
#pragma unroll
    for (int e = 1; e < 8; ++e) bw[e] = gv[8 - e];
    bw[0] = cc ? bf2f(base[4096 - 8 * cc]) : 0.f;
    float o[8];
#pragma unroll
    for (int e = 0; e < 8; ++e) o[e] = zero ? 0.f : (part ? sgn * (fw[e] - bw[e]) : fw[e] + bw[e]);
    if (cc == 0) o[0] = part ? bf2f(rowc[2048]) : fw[0];
    u32x4 ov; ov[0] = pk2(o[0], o[1]); ov[1] = pk2(o[2], o[3]); ov[2] = pk2(o[4], o[5]); ov[3] = pk2(o[6], o[7]);
    *(u32x4*)(UF + (size_t)n * 4096 + part * 2048 + 8 * cc) = ov;
  }
  u16* UP = (u16*)(p.ws + WS_UT);
  for (int it = blockIdx.x * 512 + tid; it < 32 * 512 * 2 * 32; it += gridDim.x * 512) {
    const int ck = it & 31, part = (it >> 5) & 1, ch = (it >> 6) & 511, bp = it >> 15, g = ch >> 7, m = ch & 127;
    const bool mir = m > 64, zr = part && (m == 0 || m == 64);
    if (!mir && !zr) continue;
    u32x4 v = {0u, 0u, 0u, 0u};
    if (mir) { v = *(const u32x4*)(UP + (size_t)(bp * 512 + g * 128 + 128 - m) * 512 + part * 256 + ck * 8);
      if (part) { v[0] ^= 0x80008000u; v[1] ^= 0x80008000u; v[2] ^= 0x80008000u; v[3] ^= 0x80008000u; } }
    *(u32x4*)(UP + (size_t)(bp * 512 + ch) * 512 + part * 256 + ck * 8) = v;
  }
}

__device__ __forceinline__ void phase_h(const P& p, int l, bool first, const int tid) {
  const int lane = tid & 63, gw = blockIdx.x * 8 + (tid >> 6), ngw = gridDim.x * 8;
  const float* modl = (const float*)(p.ws + WS_MOD) + (size_t)l * 5 * 3072;
  u16* H = (u16*)(p.ws + WS_H);
  float pef[4] = {0.f, 0.f, 0.f, 0.f};
  if (first) {
#pragma unroll
    for (int e = 0; e < 4; ++e) pef[e] = 1.0f / powf(10000.0f, (float)(4 * lane + e) / 256.0f);
  }
  for (int r = gw; r < NTOK; r += ngw) {
    const int j = r < NPROMPT ? 0 : 1 + ((r - NPROMPT) >> 12);
    float* xr = p.out + (size_t)r * 1024;
    f32x4 v[4];
    if (first) {
      const float* src = r < NPROMPT ? p.x_prompt + (size_t)r * 1024 : p.x_sample + (size_t)(r - NPROMPT) * 1024;
#pragma unroll
      for (int i = 0; i < 4; ++i) v[i] = *(const f32x4*)(src + 4 * (lane + 64 * i));
      if (r >= NPROMPT) {
        const int pos = (r - NPROMPT) & 4095; const float pr = (float)(pos >> 6), pc = (float)(pos & 63);
#pragma unroll
        for (int e = 0; e < 4; ++e) {
          const float fr_ = pef[e];
          v[0][e] += sinf(pr * fr_); v[1][e] += cosf(pr * fr_); v[2][e] += sinf(pc * fr_); v[3][e] += cosf(pc * fr_);
        }
      }
#pragma unroll
      for (int i = 0; i < 4; ++i) *(f32x4*)(xr + 4 * (lane + 64 * i)) = v[i];
    } else {
#pragma unroll
      for (int i = 0; i < 4; ++i) v[i] = *(const f32x4*)(xr + 4 * (lane + 64 * i));
    }
    float ss = 0.f;
#pragma unroll
    for (int i = 0; i < 4; ++i) ss += (v[i][0] * v[i][0] + v[i][1] * v[i][1]) + (v[i][2] * v[i][2] + v[i][3] * v[i][3]);
    const float rstd = rsqrtf(wave_sum(ss) * (1.f / 1024.f) + 1e-6f);
#pragma unroll
    for (int i = 0; i < 4; ++i) {
      const int e0 = 4 * (lane + 64 * i);
      const f32x4 nw = *(const f32x4*)(p.norm_w + l * 1024 + e0), sh = *(const f32x4*)(modl + j * 3072 + e0), sc = *(const f32x4*)(modl + j * 3072 + 1024 + e0);
      f32x4 hh;
#pragma unroll
      for (int e = 0; e < 4; ++e) hh[e] = (v[i][e] * rstd) * nw[e] * (1.f + sc[e]) + sh[e];
      u32x2 o; o[0] = pk2(hh[0], hh[1]); o[1] = pk2(hh[2], hh[3]);
      *(u32x2*)(H + (size_t)r * 1024 + e0) = o;
    }
  }
}

constexpr int SC_QB = 0, SC_KB = 8704, SC_KLT = 17408, SC_DEC = 26624, SC_EM = 27136, SC_P = 27648, SC_QA = 29184, SC_BUF = 37888;
__device__ __forceinline__ float ex2(float x) { return __builtin_amdgcn_exp2f(x); }
__device__ __forceinline__ void scan_chain(const P& p, int l, int seq, int hh, int dir, int mode, int seg, unsigned char* shm, int& parity, const int tid) {
  const int w = tid >> 6, lane = tid & 63, fr = lane & 15, fq = lane >> 4;
  const bool samp = seq >= 32;
  const int L = samp ? 4096 : 256, rowbase = samp ? NPROMPT + (seq - 32) * 4096 : seq * 256, nch = mode ? 32 : (L >> 5), n0 = mode ? seg * 32 : 0;
  const int chain = (seq - 32) * 16 + hh * 2 + dir;
  const long cstep = dir ? -32 * 1024 : 32 * 1024;
  const long rstr = dir ? -1024 : 1024;
  const size_t e0 = (size_t)((long)((size_t)rowbase + (dir ? L - 1 : 0)) * 1024 + hh * 128 + (long)n0 * cstep);
  const u16* Qc = (const u16*)(p.ws + WS_Q) + e0;
  const u16* LFc = (const u16*)(p.ws + (dir ? WS_LB : WS_LF)) + e0;
  const u16* Vc = (const u16*)(p.ws + WS_V) + e0;
  u16* Oc = (u16*)(p.ws + (dir ? WS_OB : WS_OF)) + e0;
  const int sg = dir ? -1 : 1;
  const int off_t = sg * (fq * 8) * 1024 + w * 16 + fr;
  const int off_c0 = sg * fr * 1024 + w * 16 + fq * 4;
  const int off_v = sg * (fq * 4) * 1024 + w * 16 + fr;
  f32x4 S[8];
  if (mode == 1 || !samp) {
#pragma unroll
    for (int cb = 0; cb < 8; ++cb) S[cb] = (f32x4){0.f, 0.f, 0.f, 0.f};
  } else {
    const float* s0 = p.state + ((((size_t)(seq - 32) * 4 + l) * 2 + dir) * 8 + hh) * 16384 + w * 16 + fr;
#pragma unroll
    for (int cb = 0; cb < 8; ++cb)
#pragma unroll
      for (int j = 0; j < 4; ++j) S[cb][j] = s0[(cb * 16 + fq * 4 + j) * 128];
    for (int g = 0; g < seg; ++g) {
      const float* sl = (const float*)(p.ws + WS_SLOC) + ((size_t)chain * 3 + g) * 16384 + w * 16 + fr;
      const float* lg = (const float*)(p.ws + WS_LSEG) + ((size_t)chain * 3 + g) * 128 + fq * 4;
#pragma unroll
      for (int cb = 0; cb < 8; ++cb) { const f32x4 lv4 = *(const f32x4*)(lg + cb * 16);
#pragma unroll
        for (int j = 0; j < 4; ++j) S[cb][j] = ex2(lv4[j]) * S[cb][j] + sl[(cb * 16 + fq * 4 + j) * 128]; }
    }
  }
  f32x4 lsum = {0.f, 0.f, 0.f, 0.f};
  bf16x8 Lm[2];
#pragma unroll
  for (int tb = 0; tb < 2; ++tb)
#pragma unroll
    for (int j = 0; j < 8; ++j) Lm[tb][j] = (fq * 8 + j <= tb * 16 + fr) ? (short)0x3F80 : (short)0;
  u16 n_lft[8], n_v[8]; u32x2 n_lfc[2], n_qc[2] = {{0u, 0u}, {0u, 0u}};
#define SC_LOAD(QP, LP, VP) do { \
    _Pragma("unroll") for (int j = 0; j < 8; ++j) n_lft[j] = ((LP) + j * rstr)[off_t]; \
    _Pragma("unroll") for (int tb = 0; tb < 2; ++tb) { n_lfc[tb] = *(const u32x2*)((LP) + tb * 16 * rstr + off_c0); if (mode != 1) n_qc[tb] = *(const u32x2*)((QP) + tb * 16 * rstr + off_c0); } \
    _Pragma("unroll") for (int i = 0; i < 8; ++i) n_v[i] = ((VP) + ((i >> 2) * 16 + (i & 3)) * rstr)[off_v]; } while (0)
  SC_LOAD(Qc, LFc, Vc);
  for (int n = 0; n < nch; ++n) {
    u16 lft[8], vv[8]; u32x2 lfc[2], qc[2];
#pragma unroll
    for (int j = 0; j < 8; ++j) { lft[j] = n_lft[j]; vv[j] = n_v[j]; }
    lfc[0] = n_lfc[0]; lfc[1] = n_lfc[1]; qc[0] = n_qc[0]; qc[1] = n_qc[1];
    u16* Ocur = Oc;
    Qc += cstep; LFc += cstep; Vc += cstep; Oc += cstep;
    if (n + 1 < nch) SC_LOAD(Qc, LFc, Vc);
    unsigned char* buf = shm + (parity & 1) * SC_BUF; parity ^= 1;
    bf16x8 ahi, alo, vop;
    {
      unsigned hb[8], lb2[8];
#pragma unroll
      for (int j = 0; j < 8; ++j) { const float x = h2f(lft[j]); const unsigned xb = __float_as_uint(x) & 0xFFFF0000u; hb[j] = xb; lb2[j] = __float_as_uint(x - __uint_as_float(xb)); }
      u32x4 ph, pl, pv;
#pragma unroll
      for (int j = 0; j < 4; ++j) { ph[j] = (hb[2 * j] >> 16) | hb[2 * j + 1]; pl[j] = (lb2[2 * j] >> 16) | (lb2[2 * j + 1] & 0xFFFF0000u); pv[j] = (unsigned)vv[2 * j] | ((unsigned)vv[2 * j + 1] << 16); }
      ahi = __builtin_bit_cast(bf16x8, ph); alo = __builtin_bit_cast(bf16x8, pl); vop = __builtin_bit_cast(bf16x8, pv);
    }
    f32x4 b[2];
#pragma unroll
    for (int tb = 0; tb < 2; ++tb) {
      b[tb] = __builtin_amdgcn_mfma_f32_16x16x32_bf16(ahi, Lm[tb], (f32x4){0.f, 0.f, 0.f, 0.f}, 0, 0, 0);
      b[tb] = __builtin_amdgcn_mfma_f32_16x16x32_bf16(alo, Lm[tb], b[tb], 0, 0, 0);
    }
    f32x4 blast, bmid, elm, emc;
#pragma unroll
    for (int j = 0; j < 4; ++j) { blast[j] = __shfl(b[1][j], (lane & 48) | 15); bmid[j] = __shfl(b[0][j], (lane & 48) | 15); elm[j] = ex2(blast[j] - bmid[j]); emc[j] = ex2(bmid[j]); }
    lsum += blast;
#pragma unroll
    for (int tb = 0; tb < 2; ++tb) {
      float qv[4], lv[4], qb[4], kb[4], kl[4];
      qv[0] = bflo(qc[tb][0]); qv[1] = bfhi(qc[tb][0]); qv[2] = bflo(qc[tb][1]); qv[3] = bfhi(qc[tb][1]);
      lv[0] = h2f((u16)(lfc[tb][0] & 0xFFFF)); lv[1] = h2f((u16)(lfc[tb][0] >> 16)); lv[2] = h2f((u16)(lfc[tb][1] & 0xFFFF)); lv[3] = h2f((u16)(lfc[tb][1] >> 16));
#pragma unroll
      for (int j = 0; j < 4; ++j) { const float kk = 1.f - ex2(lv[j]), d = b[tb][j] - bmid[j]; qb[j] = qv[j] * ex2(d); kb[j] = kk * ex2(-d); kl[j] = kb[j] * elm[j]; }
      if (mode != 1) {
        u32x2 o; o[0] = pk2(qb[0], qb[1]); o[1] = pk2(qb[2], qb[3]);
        *(u32x2*)(buf + SC_QB + (tb * 16 + fr) * 272 + (w * 16 + fq * 4) * 2) = o;
        o[0] = pk2(qb[0] * emc[0], qb[1] * emc[1]); o[1] = pk2(qb[2] * emc[2], qb[3] * emc[3]);
        *(u32x2*)(buf + SC_QA + (tb * 16 + fr) * 272 + (w * 16 + fq * 4) * 2) = o;
        o[0] = pk2(kb[0], kb[1]); o[1] = pk2(kb[2], kb[3]);
        *(u32x2*)(buf + SC_KB + (tb * 16 + fr) * 272 + (w * 16 + fq * 4) * 2) = o;
      }
      const unsigned k01 = pk2(kl[0], kl[1]), k23 = pk2(kl[2], kl[3]);
      unsigned char* kp = buf + SC_KLT + (w * 16 + fq * 4) * 72 + (tb * 16 + fr) * 2;
      *(u16*)(kp) = (u16)(k01 & 0xFFFFu); *(u16*)(kp + 72) = (u16)(k01 >> 16); *(u16*)(kp + 144) = (u16)(k23 & 0xFFFFu); *(u16*)(kp + 216) = (u16)(k23 >> 16);
    }
    if (fr == 0) { f32x4 d;
#pragma unroll
      for (int j = 0; j < 4; ++j) d[j] = emc[j] * elm[j];
      *(f32x4*)(buf + SC_DEC + (w * 16 + fq * 4) * 4) = d; }
    __syncthreads();
    f32x4 o0 = {0.f, 0.f, 0.f, 0.f}, o1 = o0;
    if (mode != 1) {
      if (w < 3) {
        __builtin_amdgcn_s_setprio(3);
        const int krow = (w == 2 ? 16 : 0) + fr, qrow = (w == 0 ? 0 : 16) + fr;
        f32x4 at = {0.f, 0.f, 0.f, 0.f};
#pragma unroll
        for (int kbk = 0; kbk < 4; ++kbk) {
          const bf16x8 kf = *(const bf16x8*)(buf + SC_KB + krow * 272 + kbk * 64 + fq * 16), qf = *(const bf16x8*)(buf + SC_QB + qrow * 272 + kbk * 64 + fq * 16);
          at = __builtin_amdgcn_mfma_f32_16x16x32_bf16(kf, qf, at, 0, 0, 0);
        }
        if (w != 1) {
#pragma unroll
          for (int j = 0; j < 4; ++j) at[j] = (fq * 4 + j <= fr) ? at[j] : 0.f;
        }
        u32x2 pw; pw[0] = pk2(at[0], at[1]); pw[1] = pk2(at[2], at[3]);
        *(u32x2*)(buf + SC_P + w * 512 + lane * 8) = pw;
        __builtin_amdgcn_s_setprio(0);
      }
#pragma unroll
      for (int kbk = 0; kbk < 4; ++kbk) {
        u32x4 sp; sp[0] = pk2(S[2 * kbk][0], S[2 * kbk][1]); sp[1] = pk2(S[2 * kbk][2], S[2 * kbk][3]); sp[2] = pk2(S[2 * kbk + 1][0], S[2 * kbk + 1][1]); sp[3] = pk2(S[2 * kbk + 1][2], S[2 * kbk + 1][3]);
        const bf16x8 sop = __builtin_bit_cast(bf16x8, sp);
        u32x4 qa, qb2;
        { const u32x2 x0 = *(const u32x2*)(buf + SC_QA + fr * 272 + kbk * 64 + fq * 8), x1 = *(const u32x2*)(buf + SC_QA + fr * 272 + kbk * 64 + 32 + fq * 8); qa[0] = x0[0]; qa[1] = x0[1]; qa[2] = x1[0]; qa[3] = x1[1]; }
        { const u32x2 x0 = *(const u32x2*)(buf + SC_QA + (16 + fr) * 272 + kbk * 64 + fq * 8), x1 = *(const u32x2*)(buf + SC_QA + (16 + fr) * 272 + kbk * 64 + 32 + fq * 8); qb2[0] = x0[0]; qb2[1] = x0[1]; qb2[2] = x1[0]; qb2[3] = x1[1]; }
        o0 = __builtin_amdgcn_mfma_f32_16x16x32_bf16(__builtin_bit_cast(bf16x8, qa), sop, o0, 0, 0, 0);
        o1 = __builtin_amdgcn_mfma_f32_16x16x32_bf16(__builtin_bit_cast(bf16x8, qb2), sop, o1, 0, 0, 0);
      }
    }
#pragma unroll
    for (int cb = 0; cb < 8; ++cb) {
      const f32x4 d = *(const f32x4*)(buf + SC_DEC + (cb * 16 + fq * 4) * 4);
      u32x4 ka; { const u32x2 x0 = *(const u32x2*)(buf + SC_KLT + (cb * 16 + fr) * 72 + fq * 8), x1 = *(const u32x2*)(buf + SC_KLT + (cb * 16 + fr) * 72 + 32 + fq * 8); ka[0] = x0[0]; ka[1] = x0[1]; ka[2] = x1[0]; ka[3] = x1[1]; }
      S[cb] = __builtin_amdgcn_mfma_f32_16x16x32_bf16(__builtin_bit_cast(bf16x8, ka), vop, d * S[cb], 0, 0, 0);
    }
    if (mode != 1) {
      __syncthreads();
      const u32x2 t0 = *(const u32x2*)(buf + SC_P + lane * 8), t1 = *(const u32x2*)(buf + SC_P + 512 + lane * 8), t2 = *(const u32x2*)(buf + SC_P + 1024 + lane * 8);
      u32x4 pp; pp[0] = t0[0]; pp[1] = t0[1]; pp[2] = 0u; pp[3] = 0u;
      o0 = __builtin_amdgcn_mfma_f32_16x16x32_bf16(__builtin_bit_cast(bf16x8, pp), vop, o0, 0, 0, 0);
      pp[0] = t1[0]; pp[1] = t1[1]; pp[2] = t2[0]; pp[3] = t2[1];
      o1 = __builtin_amdgcn_mfma_f32_16x16x32_bf16(__builtin_bit_cast(bf16x8, pp), vop, o1, 0, 0, 0);
#pragma unroll
      for (int j = 0; j < 4; j += 2) { const unsigned a = pk2(o0[j], o0[j + 1]), b = pk2(o1[j], o1[j + 1]);
        (Ocur + j * rstr)[off_v] = (u16)(a & 0xFFFFu); (Ocur + (j + 1) * rstr)[off_v] = (u16)(a >> 16); (Ocur + (16 + j) * rstr)[off_v] = (u16)(b & 0xFFFFu); (Ocur + (17 + j) * rstr)[off_v] = (u16)(b >> 16); }
    }
  }
#undef SC_LOAD
  if (mode == 1) {
    float* sl = (float*)(p.ws + WS_SLOC) + ((size_t)chain * 3 + seg) * 16384 + w * 16 + fr;
#pragma unroll
    for (int cb = 0; cb < 8; ++cb)
#pragma unroll
      for (int j = 0; j < 4; ++j) sl[(cb * 16 + fq * 4 + j) * 128] = S[cb][j];
    if (fr == 0) *(f32x4*)((float*)(p.ws + WS_LSEG) + ((size_t)chain * 3 + seg) * 128 + w * 16 + fq * 4) = lsum;
  }
  if (!samp) {
    float* ns = p.out + (size_t)NTOK * 1024 + ((((size_t)seq * 4 + l) * 2 + dir) * 8 + hh) * 16384 + w * 16 + fr;
#pragma unroll
    for (int cb = 0; cb < 8; ++cb)
#pragma unroll
      for (int j = 0; j < 4; ++j) ns[(cb * 16 + fq * 4 + j) * 128] = S[cb][j];
  }
}

__device__ __forceinline__ void phase_fin(const P& p, int l, const int tid) {
  const int lane = tid & 63, gw = blockIdx.x * 8 + (tid >> 6), ngw = gridDim.x * 8;
  const u16* OF = (const u16*)(p.ws + WS_OF); const u16* OB = (const u16*)(p.ws + WS_OB);
  const u16* ZA = (const u16*)(p.ws + WS_ZA); u16* YA = (u16*)(p.ws + WS_YAB);
  const float* gw_ = p.gnorm_w + l * 1024 + lane * 16;
  for (int r = gw; r < NTOK; r += ngw) {
    const size_t base = (size_t)r * 1024 + lane * 16;
    const u32x4 f0 = *(const u32x4*)(OF + base), f1 = *(const u32x4*)(OF + base + 8), b0 = *(const u32x4*)(OB + base), b1 = *(const u32x4*)(OB + base + 8);
    f32x4 o[4]; float ss = 0.f;
#pragma unroll
    for (int i = 0; i < 2; ++i) {
      o[i][0] = bflo(f0[2 * i]) + bflo(b0[2 * i]); o[i][1] = bfhi(f0[2 * i]) + bfhi(b0[2 * i]); o[i][2] = bflo(f0[2 * i + 1]) + bflo(b0[2 * i + 1]); o[i][3] = bfhi(f0[2 * i + 1]) + bfhi(b0[2 * i + 1]);
      o[2 + i][0] = bflo(f1[2 * i]) + bflo(b1[2 * i]); o[2 + i][1] = bfhi(f1[2 * i]) + bfhi(b1[2 * i]); o[2 + i][2] = bflo(f1[2 * i + 1]) + bflo(b1[2 * i + 1]); o[2 + i][3] = bfhi(f1[2 * i + 1]) + bfhi(b1[2 * i + 1]); }
#pragma unroll
    for (int i = 0; i < 4; ++i) ss += (o[i][0] * o[i][0] + o[i][1] * o[i][1]) + (o[i][2] * o[i][2] + o[i][3] * o[i][3]);
    ss += __shfl_xor(ss, 1); ss += __shfl_xor(ss, 2); ss += __shfl_xor(ss, 4);
    const float rstd = rsqrtf(ss * (1.f / 128.f) + 1e-6f);
    const u32x4 z0 = *(const u32x4*)(ZA + base), z1 = *(const u32x4*)(ZA + base + 8);
    float zf[16];
#pragma unroll
    for (int i = 0; i < 4; ++i) { zf[2 * i] = bflo(z0[i]); zf[2 * i + 1] = bfhi(z0[i]); zf[8 + 2 * i] = bflo(z1[i]); zf[8 + 2 * i + 1] = bfhi(z1[i]); }
    float y[16];
#pragma unroll
    for (int i = 0; i < 4; ++i) { const f32x4 g = *(const f32x4*)(gw_ + 4 * i);
#pragma unroll
      for (int e = 0; e < 4; ++e) y[4 * i + e] = o[i][e] * rstd * g[e] * zf[4 * i + e]; }
    u32x4 a, b2;
    a[0] = pk2(y[0], y[1]); a[1] = pk2(y[2], y[3]); a[2] = pk2(y[4], y[5]); a[3] = pk2(y[6], y[7]);
    b2[0] = pk2(y[8], y[9]); b2[1] = pk2(y[10], y[11]); b2[2] = pk2(y[12], y[13]); b2[3] = pk2(y[14], y[15]);
    *(u32x4*)(YA + (size_t)r * 1536 + lane * 16) = a; *(u32x4*)(YA + (size_t)r * 1536 + lane * 16 + 8) = b2;
  }
}

__device__ __forceinline__ void phase_final(const P& p, const int tid) {
  const int lane = tid & 63, gw = blockIdx.x * 8 + (tid >> 6), ngw = gridDim.x * 8;
  for (int r = gw; r < NTOK; r += ngw) {
    float* xr = p.out + (size_t)r * 1024;
    f32x4 v[4]; float ss = 0.f;
#pragma unroll
    for (int i = 0; i < 4; ++i) { v[i] = *(const f32x4*)(xr + 4 * (lane + 64 * i)); ss += (v[i][0] * v[i][0] + v[i][1] * v[i][1]) + (v[i][2] * v[i][2] + v[i][3] * v[i][3]); }
    const float rstd = rsqrtf(wave_sum(ss) * (1.f / 1024.f) + 1e-6f);
#pragma unroll
    for (int i = 0; i < 4; ++i) { const f32x4 fw = *(const f32x4*)(p.final_w + 4 * (lane + 64 * i)); *(f32x4*)(xr + 4 * (lane + 64 * i)) = v[i] * rstd * fw; }
  }
}

#define XB_TMO      128
#define XB_XCNT(j)  (256  + 64 * (j))
#define XB_XSUB(j)  (1280 + 64 * (j))
#define XB_XGEN(j)  (2304 + 64 * (j))
#define XB_TOP      3328
#define XB_TOPGEN   3392
#define XCD_BAR_WORDS 3456
#define XB_SPIN_CAP (1u << 18)
__device__ __forceinline__ unsigned xb_ld(unsigned* p)              { return __hip_atomic_load(p, __ATOMIC_RELAXED, __HIP_MEMORY_SCOPE_AGENT); }
__device__ __forceinline__ unsigned xb_add(unsigned* p, unsigned v) { return __hip_atomic_fetch_add(p, v, __ATOMIC_RELAXED, __HIP_MEMORY_SCOPE_AGENT); }
__device__ __forceinline__ unsigned xb_xcc_id() { return (unsigned)__builtin_amdgcn_s_getreg((3 << 11) | 20) & 0xFu; }
#define XB_SPIN(cond, bar) do { unsigned _sp = 0; while (cond) { __builtin_amdgcn_s_sleep(1); \
    if ((++_sp & 255u) == 0u) { if (xb_ld(&(bar)[XB_TMO])) break; if (_sp > XB_SPIN_CAP) { atomicAdd(&(bar)[XB_TMO], 1u); break; } } } } while (0)
__device__ __forceinline__ void xcd_barrier_complete(unsigned* bar, unsigned x, unsigned& nloc, unsigned& nx) {
    const unsigned G = gridDim.x * gridDim.y * gridDim.z;
    unsigned sum, cnt, mine, sp = 0u;
    for (;;) {
        sum = 0u; cnt = 0u; mine = 0u;
#pragma unroll
        for (unsigned j = 0; j < 16; ++j) { const unsigned c = xb_ld(&bar[XB_XCNT(j)]); sum += c; cnt += (c > 0u) ? 1u : 0u; mine = (j == x) ? c : mine; }
        if (sum == G) break;
        __builtin_amdgcn_s_sleep(1);
        if ((++sp & 255u) == 0u) { if (xb_ld(&bar[XB_TMO])) break; if (sp > XB_SPIN_CAP) { atomicAdd(&bar[XB_TMO], 1u); break; } }
    }
    nloc = mine > 0u ? mine : 1u; nx = cnt > 0u ? cnt : 1u;
}
__device__ __forceinline__ void xcd_barrier(unsigned* bar, volatile LAS unsigned* st, const int tid) {
    asm volatile("s_waitcnt vmcnt(0)" ::: "memory");
    __syncthreads();
    if (tid == 0) {
        const unsigned x = xb_xcc_id();
        __builtin_amdgcn_s_waitcnt(0);
        unsigned nloc = st[0], nx = st[1];
        if (nloc == 0u) { xcd_barrier_complete(bar, x, nloc, nx); st[0] = nloc; st[1] = nx; }
        const unsigned old = xb_add(&bar[XB_XSUB(x)], 1u);
        const unsigned gen = old / nloc;
        if (old + 1u == (gen + 1u) * nloc) {
            __builtin_amdgcn_fence(__ATOMIC_RELEASE, "agent");
            asm volatile("s_waitcnt vmcnt(0)" ::: "memory");
            const unsigned og = xb_add(&bar[XB_TOP], 1u);
            const unsigned tg = og / nx;
            if (og + 1u == (tg + 1u) * nx) xb_add(&bar[XB_TOPGEN], 1u);
            else XB_SPIN(xb_ld(&bar[XB_TOPGEN]) == tg, bar);
            __builtin_amdgcn_fence(__ATOMIC_ACQUIRE, "agent");
            xb_add(&bar[XB_XGEN(x)], 1u);
            asm volatile("s_waitcnt vmcnt(0)" ::: "memory");
        } else {
            XB_SPIN(xb_ld(&bar[XB_XGEN(x)]) == gen, bar);
            __builtin_amdgcn_fence(__ATOMIC_ACQUIRE, "agent");
            asm volatile("s_waitcnt vmcnt(0)" ::: "memory");
        }
    }
    __syncthreads();
}

struct EpiAll {
  int type, perm;
  unsigned char* ws; float* x; const float* f0; int rowbase, lshift; float scale; int pm0;
  __device__ __forceinline__ void operator()(const Acc& acc, const Unit& u0, int wr, int wc, int fr, int fq) const {
    asm volatile("" : "+v"(fr), "+v"(fq));
    Unit u = u0; u.pm += pm0;
    switch (type) {
      case 0: { EpiG1 E{ws, f0}; E(acc, u, wr, wc, fr, fq); break; }
      case 1: { EpiDFT E{ws, rowbase, lshift, scale}; E(acc, u, wr, wc, fr, fq); break; }
      case 2: { EpiG2 E{ws}; E(acc, u, wr, wc, fr, fq); break; }
      default: { EpiG3 E{x, f0}; E(acc, u, wr, wc, fr, fq); break; }
    }
  }
  __device__ __forceinline__ void hook(Acc& acc, const Unit& u0, int wr, int wc, int fr, int fq) const {
    asm volatile("" : "+v"(fr), "+v"(fq));
    Unit u = u0; u.pm += pm0;
    EpiG2 E{ws}; E.hook(acc, u, wr, wc, fr, fq);
  }
};

__global__ void __launch_bounds__(512, 2) fwd_megakernel(P p_arg) {
#if defined(__HIP_DEVICE_COMPILE__)
  extern __shared__ __attribute__((aligned(16))) unsigned char shm[];
  cg::grid_group grid = cg::this_grid();
  LAS unsigned char* lds = (LAS unsigned char*)shm;
  const int bid = blockIdx.x, G = gridDim.x;
  volatile LAS unsigned* xb_st = (volatile LAS unsigned*)(lds + 131072);
  if (threadIdx.x == 0) { xb_st[0] = 0u; xb_st[1] = 0u; }
  __syncthreads();
  for (int si = 0; si < 64; ++si) {
    const __attribute__((address_space(4))) P* pp = (const __attribute__((address_space(4))) P*)__builtin_amdgcn_kernarg_segment_ptr(); asm volatile("" : "+s"(pp));
    const unsigned code = pp->prog[si];
    if (code == 0xFFu) break;
    P p;
    p.x_prompt = pp->x_prompt; p.x_sample = pp->x_sample; p.state = pp->state; p.c = pp->c; p.c_ctx = pp->c_ctx; p.norm_w = pp->norm_w; p.w_ada = pp->w_ada; p.b_ada = pp->b_ada; p.w_in = pp->w_in;
    p.lb_raw = pp->lb_raw; p.gnorm_w = pp->gnorm_w; p.w_pa = pp->w_pa; p.w_pb = pp->w_pb; p.w_o = pp->w_o; p.final_w = pp->final_w; p.out = pp->out; p.ws = pp->ws;
    unsigned char* ws = p.ws;
    int tid = threadIdx.x; asm volatile("" : "+v"(tid));
    const int k = code & 15, l = (code >> 4) & 3;
    if (k == 8) { if (bid == 0) for (int i = tid; i < XCD_BAR_WORDS; i += 512) ((unsigned*)ws)[i] = 0u;
      p0_prologue(p, shm, tid); }
    else if (k == 9) { phase_final(p, tid); }
    else if (k == 0) phase_h(p, l, l == 0, tid);
    else if (k == 3) {
      int parity = 0;
      if (bid < 128) { for (int ci = 256 + bid * 2; ci < 256 + bid * 2 + 2; ++ci) scan_chain(p, l, ci >> 4, (ci >> 1) & 7, ci & 1, 0, 0, shm, parity, tid); }
      else {
        const int b2 = bid - 128;
        for (int ci = b2 * 2; ci < b2 * 2 + 2; ++ci) scan_chain(p, l, ci >> 4, (ci >> 1) & 7, ci & 1, 0, 0, shm, parity, tid);
        const int a0 = b2 < 64 ? b2 : 64 + (b2 - 64) * 2, an = b2 < 64 ? 1 : 2;
        for (int ai = a0; ai < a0 + an; ++ai) { const int ch = ai / 3, sg = ai - ch * 3; scan_chain(p, l, 32 + (ch >> 4), (ch >> 1) & 7, ch & 1, 1, sg, shm, parity, tid); }
      }
    }
    else if (k == 11) {
      int parity = 0; const int ch = bid >> 2, sg = bid & 3;
      scan_chain(p, l, 32 + (ch >> 4), (ch >> 1) & 7, ch & 1, 2, sg, shm, parity, tid);
    }
    else if (k == 4) phase_fin(p, l, tid);
    else if (k == 10) { }
    else if (k == 12) phase_fold(p, tid);
    else {
      Gemm g; StaticOrder S; EpiAll E; E.ws = ws; E.x = p.out; E.f0 = nullptr; E.rowbase = 0; E.lshift = 0; E.scale = 0.f; E.pm0 = 0;
      if (k == 1) { g = Gemm{(const u16*)(ws + WS_H), (const u16*)(ws + WS_WIN) + (size_t)l * NG1 * 1024, NTOK, NG1, 1024}; S.init(NTOK, NG1, G, bid);
        E.type = 0; E.perm = 1; E.f0 = (const float*)(ws + WS_LBS) + l * 2048; }
      else if (k == 2) {
        E.type = 1; E.perm = 1;
        if (bid < 128) { g = Gemm{(const u16*)(ws + WS_DFTS), (const u16*)(ws + WS_H), 4096, 2048, 4096}; S.init(4096, 2048, 128, bid);
          E.rowbase = NPROMPT; E.lshift = 12; E.scale = 0.001381067932f; }
        else { g = Gemm{(const u16*)(ws + WS_DFTP), (const u16*)(ws + WS_UT), 256, 16384, 512}; S.init(256, 16384, 64, bid < 192 ? bid - 128 : -1);
          E.rowbase = 0; E.lshift = 8; E.scale = 0.005524271728f; }
      }
      else {
        const bool isG2 = (k == 5) || (k == 6 && bid < 128);
        const int p0 = (k == 5) ? 0 : (k == 6 ? (bid < 128 ? 64 : 0) : 32), np = (k == 6) ? 32 : 64;
        const int gsz = (k == 6) ? 128 : G, gc = (k == 6 && bid >= 128) ? bid - 128 : bid;
        E.pm0 = p0; E.perm = 0;
        if (isG2) { g = Gemm{(const u16*)(ws + WS_YAB) + (size_t)p0 * 256 * 1536, (const u16*)(ws + WS_WPA) + (size_t)l * 1024 * 1536, np * 256, 1024, 1536}; E.type = 2; }
        else { g = Gemm{(const u16*)(ws + WS_MERGED) + (size_t)p0 * 256 * 1024, (const u16*)(ws + WS_WO) + (size_t)l * 1024 * 1024, np * 256, 1024, 1024}; E.type = 4; E.f0 = (const float*)(ws + WS_MOD) + (size_t)l * 5 * 3072; }
        S.init(np * 256, 1024, gsz, gc);
      }
      pg8::gemm_phase(lds, g, S, E, tid);
      __syncthreads();
    }
    if (code & 0x80u) {
      if (k == 8) { grid.sync(); if (tid == 0) (void)xb_add(&((unsigned*)ws)[XB_XCNT(xb_xcc_id())], 1u); }
      else xcd_barrier((unsigned*)ws, xb_st, tid);
    }
  }
#endif
}

extern "C" void kernel_launch(void* const* d_in, const int* in_sizes, int n_in, void* d_out, int out_size,
                              void* d_ws, size_t ws_size, hipStream_t stream) {
  static int grid_blocks = 0;
  if (!grid_blocks) {
    int dev = 0, cus = 0, per_cu = 0;
    if (n_in != 15 || ws_size < WS_END) { fprintf(stderr, "kernel_launch: unexpected inputs / workspace (%d, %zu)\n", n_in, ws_size); grid_blocks = -1; return; }
    (void)hipGetDevice(&dev);
    (void)hipDeviceGetAttribute(&cus, hipDeviceAttributeMultiprocessorCount, dev);
    (void)hipFuncSetAttribute((const void*)fwd_megakernel, hipFuncAttributeMaxDynamicSharedMemorySize, LDS_BYTES);
    (void)hipOccupancyMaxActiveBlocksPerMultiprocessor(&per_cu, (const void*)fwd_megakernel, 512, LDS_BYTES);
    if (per_cu < 1 || cus < 256) { fprintf(stderr, "kernel_launch: occupancy %d x %d CUs cannot hold the 256-workgroup grid\n", per_cu, cus); grid_blocks = -1; return; }
    grid_blocks = 256;
  }
  if (grid_blocks < 0) return;
  P p{};
  p.x_prompt = (const float*)d_in[0]; p.x_sample = (const float*)d_in[1]; p.state = (const float*)d_in[2]; p.c = (const float*)d_in[3]; p.c_ctx = (const float*)d_in[4];
  p.norm_w = (const float*)d_in[5]; p.w_ada = (const float*)d_in[6]; p.b_ada = (const float*)d_in[7]; p.w_in = (const float*)d_in[8]; p.lb_raw = (const float*)d_in[9];
  p.gnorm_w = (const float*)d_in[10]; p.w_pa = (const float*)d_in[11]; p.w_pb = (const float*)d_in[12]; p.w_o = (const float*)d_in[13]; p.final_w = (const float*)d_in[14];
  p.out = (float*)d_out; p.ws = (unsigned char*)d_ws;
  {
#ifndef REPMASK
#define REPMASK 0
#endif
    static const unsigned char nosync[13] = {0, 0, 1, 0, 0, 0, 0, 0, 0, 1, 0, 0, 0};
    int n = 0;
    auto emit = [&](int k, int l) { const int reps = ((REPMASK >> k) & 1) ? 2 : 1;
      for (int r = 0; r < reps; ++r) p.prog[n++] = (unsigned char)(k | (l << 4) | ((nosync[k] && r + 1 == reps) ? 0 : 0x80)); };
    emit(8, 0);
    for (int l = 0; l < DEPTH; ++l) for (int k = 0; k < 8; ++k) { if (k == 2) emit(12, l); emit(k, l); if (k == 3) emit(11, l); }
#ifdef NOPSYNCS
    for (int i = 0; i < NOPSYNCS; ++i) p.prog[n++] = (unsigned char)(10 | 0x80);
#endif
    emit(9, 0);
    while (n < 64) p.prog[n++] = 0xFF;
  }
  void* args[] = {&p};
  hipError_t e = hipLaunchCooperativeKernel((void*)fwd_megakernel, dim3(grid_blocks), dim3(512), args, LDS_BYTES, stream);
  if (e != hipSuccess) fprintf(stderr, "cooperative launch failed: %s\n", hipGetErrorString(e));
}
```
